# Optimizing an MI355X kernel written in HIP

```python
import jax, jax.numpy as jnp
from jax import lax
import numpy as np

D_MODEL = 4096
BATCH = 4
SEQ = 2048
DEPTH = 1
DEC_BATCH = 128
DEC_SEQ = 4
PAST_LEN = 16384
PAGE_SIZE = 128

N_MEM = 256
D_POOL = 3 * D_MODEL // 8
D_CONV = 3 * D_MODEL // 8
D_XATTN = D_MODEL - D_POOL - D_CONV
N_XHEADS = 4
XHEAD_DIM = D_XATTN // N_XHEADS
POOL_WINDOWS = (2, 4, 8, 16)
N_POOL_GROUPS = len(POOL_WINDOWS)
POOL_GROUP = D_POOL // N_POOL_GROUPS
POOL_STATE = max(POOL_WINDOWS) - 1
CONV_WIDTH = 31
CONV_STATE = CONV_WIDTH - 1
D_IN = 2 * D_POOL + 3 * D_CONV + 2 * D_XATTN
EPS = 1e-6

kernel_name = "pool_conv_memory_hybrid_step"


def rmsnorm(x, g):
    xf = x.astype(jnp.float32)
    y = xf * lax.rsqrt(jnp.mean(xf * xf, axis=-1, keepdims=True) + EPS) * g.astype(jnp.float32)
    return y.astype(x.dtype)


def layernorm(x, g, b):
    xf = x.astype(jnp.float32)
    mu = jnp.mean(xf, axis=-1, keepdims=True)
    var = jnp.mean(jnp.square(xf - mu), axis=-1, keepdims=True)
    y = (xf - mu) * lax.rsqrt(var + EPS) * g.astype(jnp.float32) + b.astype(jnp.float32)
    return y.astype(x.dtype)


def memory_kv(mem, mem_norm_g, w_mem_k, w_mem_v):
    h = rmsnorm(mem, mem_norm_g)
    b = mem.shape[0]
    k = (h @ w_mem_k).reshape(b, N_MEM, N_XHEADS, XHEAD_DIM)
    v = (h @ w_mem_v).reshape(b, N_MEM, N_XHEADS, XHEAD_DIM)
    return k, v


def pool_mix(u, state, start_pos, w_pool, pool_scale):
    b, t, _ = u.shape
    ext = jnp.concatenate([state.astype(u.dtype), u], axis=1).astype(jnp.float32)
    cs = jnp.pad(jnp.cumsum(ext, axis=1), ((0, 0), (1, 0), (0, 0)))
    end = cs[:, POOL_STATE + 1:POOL_STATE + 1 + t]
    pos = start_pos + jnp.arange(t, dtype=jnp.int32)
    means = []
    for gi, w in enumerate(POOL_WINDOWS):
        lo_c, hi_c = gi * POOL_GROUP, (gi + 1) * POOL_GROUP
        lo = cs[:, POOL_STATE + 1 - w:POOL_STATE + 1 - w + t, lo_c:hi_c]
        cnt = jnp.minimum(w, pos + 1).astype(jnp.float32)[None, :, None]
        means.append((end[..., lo_c:hi_c] - lo) / cnt)
    pooled = jnp.concatenate(means, axis=-1) - ext[:, POOL_STATE:]
    mixed = jnp.einsum('btgc,gcd->btgd', pooled.reshape(b, t, N_POOL_GROUPS, POOL_GROUP),
                       w_pool.astype(jnp.float32)).reshape(b, t, D_POOL)
    mixed = mixed * pool_scale.astype(jnp.float32)
    return mixed.astype(u.dtype), ext[:, -POOL_STATE:].astype(u.dtype)


def conv_module(a, state, w_dw, b_dw, ln_g, ln_b, w_pw):
    ext = jnp.concatenate([state.astype(a.dtype), a], axis=1)
    y = lax.conv_general_dilated(ext, w_dw.astype(a.dtype)[:, None, :], window_strides=(1,), padding='VALID',
                                 dimension_numbers=('NWC', 'WIO', 'NWC'), feature_group_count=D_CONV)
    y = y + b_dw
    y = layernorm(y, ln_g, ln_b)
    y = jax.nn.silu(y) @ w_pw
    return y, ext[:, -CONV_STATE:]


def memory_attention(q, k, v):
    s = jnp.einsum('bthe,bmhe->bhtm', q.astype(jnp.float32), k.astype(jnp.float32)) * (XHEAD_DIM ** -0.5)
    p = jax.nn.softmax(s, axis=-1)
    o = jnp.einsum('bhtm,bmhe->bthe', p, v.astype(jnp.float32))
    b, t = q.shape[0], q.shape[1]
    return o.reshape(b, t, D_XATTN).astype(q.dtype)


def hybrid_layer(x, mem_k, mem_v, pool_state, conv_state, start_pos, norm_g, w_in, w_pool, pool_scale,
                 w_dw, b_dw, conv_ln_g, conv_ln_b, w_pw, w_out):
    b, t, _ = x.shape
    h = rmsnorm(x, norm_g)
    z = h @ w_in
    splits = np.cumsum([D_POOL, D_POOL, D_CONV, D_CONV, D_CONV, D_XATTN]).tolist()
    u_a, gate_a, glu_val, glu_gate, gate_b, q, gate_c = jnp.split(z, splits, axis=-1)
    o_a, new_pool = pool_mix(u_a, pool_state, start_pos, w_pool, pool_scale)
    o_a = o_a * jax.nn.silu(gate_a)
    a = glu_val * jax.nn.sigmoid(glu_gate)
    o_b, new_conv = conv_module(a, conv_state, w_dw, b_dw, conv_ln_g, conv_ln_b, w_pw)
    o_b = o_b * jax.nn.silu(gate_b)
    o_c = memory_attention(q.reshape(b, t, N_XHEADS, XHEAD_DIM), mem_k, mem_v) * jax.nn.silu(gate_c)
    y = x + jnp.concatenate([o_a, o_b, o_c], axis=-1) @ w_out
    return y, new_pool, new_conv


def setup_inputs(seed: int = 0) -> dict:
    key = jax.random.key(seed)
    ks = jax.random.split(key, 24)
    f32 = jnp.float32
    nrm = lambda k, shape, scale: jax.random.normal(k, shape, f32) * scale
    return {
        "x_prompt": nrm(ks[0], (BATCH, SEQ, D_MODEL), 1.0),
        "mem_prompt": nrm(ks[1], (BATCH, N_MEM, D_MODEL), 1.0),
        "x_sample": nrm(ks[2], (DEC_BATCH, DEC_SEQ, D_MODEL), 1.0),
        "cache_mem_k": nrm(ks[3], (DEPTH, DEC_BATCH, N_MEM, N_XHEADS, XHEAD_DIM), 1.0),
        "cache_mem_v": nrm(ks[4], (DEPTH, DEC_BATCH, N_MEM, N_XHEADS, XHEAD_DIM), 1.0),
        "state_pool": nrm(ks[5], (DEPTH, DEC_BATCH, POOL_STATE, D_POOL), 1.0),
        "state_conv": nrm(ks[6], (DEPTH, DEC_BATCH, CONV_STATE, D_CONV), 0.5),
        "norm_g": 1.0 + nrm(ks[7], (DEPTH, D_MODEL), 0.02),
        "mem_norm_g": 1.0 + nrm(ks[8], (DEPTH, D_MODEL), 0.02),
        "w_in": nrm(ks[9], (DEPTH, D_MODEL, D_IN), D_MODEL ** -0.5),
        "w_mem_k": nrm(ks[10], (DEPTH, D_MODEL, D_XATTN), D_MODEL ** -0.5),
        "w_mem_v": nrm(ks[11], (DEPTH, D_MODEL, D_XATTN), D_MODEL ** -0.5),
        "w_pool": nrm(ks[12], (DEPTH, N_POOL_GROUPS, POOL_GROUP, POOL_GROUP), POOL_GROUP ** -0.5),
        "pool_scale": 1.0 + nrm(ks[13], (DEPTH, D_POOL), 0.02),
        "w_dw": nrm(ks[14], (DEPTH, CONV_WIDTH, D_CONV), CONV_WIDTH ** -0.5),
        "b_dw": nrm(ks[15], (DEPTH, D_CONV), 0.01),
        "conv_ln_g": 1.0 + nrm(ks[16], (DEPTH, D_CONV), 0.02),
        "conv_ln_b": nrm(ks[17], (DEPTH, D_CONV), 0.01),
        "w_pw": nrm(ks[18], (DEPTH, D_CONV, D_CONV), D_CONV ** -0.5),
        "w_out": nrm(ks[19], (DEPTH, D_MODEL, D_MODEL), D_MODEL ** -0.5),
        "final_norm_g": 1.0 + nrm(ks[20], (D_MODEL,), 0.02),
    }


def reference(x_prompt, mem_prompt, x_sample, cache_mem_k, cache_mem_v, state_pool, state_conv,
              norm_g, mem_norm_g, w_in, w_mem_k, w_mem_v, w_pool, pool_scale, w_dw, b_dw,
              conv_ln_g, conv_ln_b, w_pw, w_out, final_norm_g):
    hp, hs = x_prompt, x_sample
    mk_p, mv_p, pool_p, conv_p, pool_s, conv_s = [], [], [], [], [], []
    for l in range(DEPTH):
        k_p, v_p = memory_kv(mem_prompt, mem_norm_g[l], w_mem_k[l], w_mem_v[l])
        zero_pool = jnp.zeros((BATCH, POOL_STATE, D_POOL), hp.dtype)
        zero_conv = jnp.zeros((BATCH, CONV_STATE, D_CONV), hp.dtype)
        hp, np_p, nc_p = hybrid_layer(hp, k_p, v_p, zero_pool, zero_conv, 0, norm_g[l], w_in[l], w_pool[l],
                                      pool_scale[l], w_dw[l], b_dw[l], conv_ln_g[l], conv_ln_b[l], w_pw[l], w_out[l])
        hs, np_s, nc_s = hybrid_layer(hs, cache_mem_k[l], cache_mem_v[l], state_pool[l], state_conv[l], PAST_LEN,
                                      norm_g[l], w_in[l], w_pool[l], pool_scale[l], w_dw[l], b_dw[l],
                                      conv_ln_g[l], conv_ln_b[l], w_pw[l], w_out[l])
        mk_p.append(k_p)
        mv_p.append(v_p)
        pool_p.append(np_p)
        conv_p.append(nc_p)
        pool_s.append(np_s)
        conv_s.append(nc_s)
    y_prompt = rmsnorm(hp, final_norm_g)
    y_sample = rmsnorm(hs, final_norm_g)
    return (y_prompt, y_sample, jnp.stack(mk_p), jnp.stack(mv_p), jnp.stack(pool_p), jnp.stack(conv_p),
            jnp.stack(pool_s), jnp.stack(conv_s))
```

```cpp
#include <hip/hip_runtime.h>
#include <cstdio>
#include <cstdint>

#define LAS __attribute__((address_space(3)))
#define GAS __attribute__((address_space(1)))
typedef unsigned short bf16_t;
typedef short bf16x8 __attribute__((ext_vector_type(8)));
typedef float f32x4 __attribute__((ext_vector_type(4)));
typedef float f32x2 __attribute__((ext_vector_type(2)));
typedef unsigned u32x4 __attribute__((ext_vector_type(4)));
typedef unsigned u32x2 __attribute__((ext_vector_type(2)));
typedef GAS unsigned gu32;

constexpr int DM = 4096, NB = 4, SEQ = 2048, DB = 128, DS = 4, NMEM = 256;
constexpr int DPOOL = 1536, DCONV = 1536, DX = 1024, NH = 4, HD = 256, PGRP = 384, DIN = 9728;
constexpr int MP = NB * SEQ, MS = DB * DS, MT = MP + MS, MM = NB * NMEM;
constexpr int PSTATE = 15, CSTATE = 30, CW = 31;
constexpr float EPS = 1e-6f;

constexpr size_t O_Y = 0;
constexpr size_t O_MK = (size_t)MT * DM;
constexpr size_t O_MV = O_MK + (size_t)MM * DX;
constexpr size_t O_PSP = O_MV + (size_t)MM * DX;
constexpr size_t O_CSP = O_PSP + (size_t)NB * PSTATE * DPOOL;
constexpr size_t O_PSS = O_CSP + (size_t)NB * CSTATE * DCONV;
constexpr size_t O_CSS = O_PSS + (size_t)DB * PSTATE * DPOOL;
constexpr size_t O_END = O_CSS + (size_t)DB * CSTATE * DCONV;

constexpr size_t MiB = 1u << 20;
constexpr size_t WS_CTL = 0, CTL_BYTES = 1 * MiB;
constexpr size_t WS_WOUT = 1 * MiB;
constexpr size_t WS_WPW = WS_WOUT + 32 * MiB;
constexpr size_t WS_WPOOL = WS_WPW + 5 * MiB;
constexpr size_t WS_WPOOLF = WS_WPOOL + 2 * MiB;
constexpr size_t WS_U = WS_WPOOLF + 2 * MiB;
constexpr size_t WS_SGA = WS_U + 26 * MiB;
constexpr size_t WS_A = WS_SGA + 26 * MiB;
constexpr size_t WS_SGB = WS_A + 26 * MiB;
constexpr size_t WS_Q = WS_SGB + 26 * MiB;
constexpr size_t WS_SGC = WS_Q + 17 * MiB;
constexpr size_t WS_KP = WS_SGC + 17 * MiB;
constexpr size_t WS_VPT = WS_KP + 2 * MiB;
constexpr size_t WS_POOLED = WS_VPT + 2 * MiB;
constexpr size_t WS_CACT = WS_POOLED + 26 * MiB;
constexpr size_t WS_CAT = WS_CACT + 26 * MiB;
constexpr size_t WS_SLAB = WS_CAT + 68 * MiB;
constexpr size_t WS_ROWSS = WS_SLAB + 64 * MiB;
constexpr size_t WS_YH = WS_ROWSS + 2 * MiB;
constexpr size_t WS_HM = WS_YH + 64 * MiB;
constexpr size_t WS_H = WS_HM + 8 * MiB;
constexpr size_t WS_WKV = WS_H + 68 * MiB;
constexpr size_t WS_WIN = WS_WKV + 16 * MiB;
constexpr size_t WS_END = WS_WIN + 76 * MiB;
constexpr int CW_BAR = 4096;
constexpr int CW_QREADY = 8192;
constexpr size_t CTL_ZERO_BYTES = 40 * 1024;
static_assert((CW_QREADY + 64) * 4 <= (int)CTL_ZERO_BYTES && (CW_BAR + 3456 + 64) * 4 <= (int)CTL_ZERO_BYTES, "ctl");

constexpr int RING_BYTES = 131072;
constexpr int LDS_BYTES = 163840;
constexpr int LDSCTL_OFF = LDS_BYTES - 1024;
constexpr int NWAVES = 8, NTHR = 512;

#define RLX_AGENT __ATOMIC_RELAXED, __HIP_MEMORY_SCOPE_AGENT
#define LDS_WAIT() asm volatile("s_waitcnt lgkmcnt(0)" ::: "memory")
#define VM_WAIT() asm volatile("s_waitcnt vmcnt(0)" ::: "memory")

__device__ __forceinline__ unsigned cvt_pk_bf16(float lo, float hi) { unsigned r; asm volatile("v_cvt_pk_bf16_f32 %0, %1, %2" : "=v"(r) : "v"(lo), "v"(hi)); return r; }
__device__ __forceinline__ float bf_lo(unsigned w) { return __uint_as_float(w << 16); }
__device__ __forceinline__ float bf_hi(unsigned w) { return __uint_as_float(w & 0xffff0000u); }
__device__ __forceinline__ float fast_sigmoid(float x) { return __builtin_amdgcn_rcpf(1.0f + __builtin_amdgcn_exp2f(-1.44269504089f * x)); }
__device__ __forceinline__ float fast_silu(float x) { return x * fast_sigmoid(x); }
__device__ __forceinline__ float wave_reduce32(float (&v)[32], int lane) {
#pragma unroll
    for (int s = 0; s < 5; ++s) { const int half = 16 >> s; const bool up = (lane >> s) & 1;
#pragma unroll
        for (int i = 0; i < half; ++i) { const float keep = up ? v[i + half] : v[i], send = up ? v[i] : v[i + half]; v[i] = keep + __shfl_xor(send, 1 << s); } }
    return v[0] + __shfl_xor(v[0], 32);
}
template <class T> __device__ __forceinline__ T ldg_nt(const void* ubase, unsigned boff) { return __builtin_nontemporal_load((const GAS T*)((const char*)ubase + boff)); }
template <class T> __device__ __forceinline__ T ldg(const void* ubase, unsigned boff) { return *(const GAS T*)((const char*)ubase + boff); }
__device__ __forceinline__ float wave_sum(float v) {
#pragma unroll
    for (int o = 1; o < 64; o <<= 1) v += __shfl_xor(v, o);
    return v;
}

__device__ __forceinline__ int fresh_tid() { int t = threadIdx.x; asm volatile("" : "+v"(t)); return t; }

#define XB_TMO      128
#define XB_XCNT(j)  (256  + 64 * (j))
#define XB_XSUB(j)  (1280 + 64 * (j))
#define XB_XGEN(j)  (2304 + 64 * (j))
#define XB_TOP      3328
#define XB_TOPGEN   3392
#define XCD_BAR_WORDS 3456
#define XB_SPIN_CAP (1u << 18)
__device__ __forceinline__ unsigned xb_ld(unsigned* p)              { return __hip_atomic_load(p, __ATOMIC_RELAXED, __HIP_MEMORY_SCOPE_AGENT); }
__device__ __forceinline__ unsigned xb_add(unsigned* p, unsigned v) { return __hip_atomic_fetch_add(p, v, __ATOMIC_RELAXED, __HIP_MEMORY_SCOPE_AGENT); }
__device__ __forceinline__ unsigned xb_xcc_id() { return (unsigned)__builtin_amdgcn_s_getreg((3 << 11) | 20) & 0xFu; }
#define XB_SPIN(cond, bar) do { unsigned _sp = 0; while (cond) { __builtin_amdgcn_s_sleep(1); \
    if ((++_sp & 255u) == 0u) { if (xb_ld(&(bar)[XB_TMO])) break; if (_sp > XB_SPIN_CAP) { atomicAdd(&(bar)[XB_TMO], 1u); break; } } } } while (0)
struct XcdBarrier { unsigned* bar; unsigned x; volatile LAS unsigned* st; };
__device__ __forceinline__ XcdBarrier xcd_barrier_post(unsigned* bar, volatile LAS unsigned* st) {
    XcdBarrier b; b.bar = bar; b.x = xb_xcc_id(); b.st = st;
    if (threadIdx.x == 0) (void)xb_add(&bar[XB_XCNT(b.x)], 1u);
    return b;
}
__device__ __forceinline__ void xcd_barrier_complete(unsigned* bar, unsigned x, unsigned& nloc, unsigned& nx) {
    const unsigned G = gridDim.x * gridDim.y * gridDim.z;
    unsigned sum, cnt, mine, sp = 0u;
    for (;;) {
        sum = 0u; cnt = 0u; mine = 0u;
#pragma unroll
        for (unsigned j = 0; j < 16; ++j) { const unsigned c = xb_ld(&bar[XB_XCNT(j)]); sum += c; cnt += (c > 0u) ? 1u : 0u; mine = (j == x) ? c : mine; }
        if (sum == G) break;
        __builtin_amdgcn_s_sleep(1);
        if ((++sp & 255u) == 0u) { if (xb_ld(&bar[XB_TMO])) break; if (sp > XB_SPIN_CAP) { atomicAdd(&bar[XB_TMO], 1u); break; } }
    }
    nloc = mine > 0u ? mine : 1u; nx = cnt > 0u ? cnt : 1u;
}
__device__ __forceinline__ void xcd_barrier(const XcdBarrier& b) {
    asm volatile("s_waitcnt vmcnt(0)" ::: "memory");
    __syncthreads();
    if (threadIdx.x == 0) {
        unsigned* bar = b.bar;
        __builtin_amdgcn_s_waitcnt(0);
        unsigned nloc = b.st[0], nx = b.st[1];
        if (nloc == 0u) { xcd_barrier_complete(bar, b.x, nloc, nx); b.st[0] = nloc; b.st[1] = nx; }
        const unsigned old = xb_add(&bar[XB_XSUB(b.x)], 1u);
        const unsigned gen = old / nloc;
        if (old + 1u == (gen + 1u) * nloc) {
            __builtin_amdgcn_fence(__ATOMIC_RELEASE, "agent");
            asm volatile("s_waitcnt vmcnt(0)" ::: "memory");
            const unsigned og = xb_add(&bar[XB_TOP], 1u);
            const unsigned tg = og / nx;
            if (og + 1u == (tg + 1u) * nx) xb_add(&bar[XB_TOPGEN], 1u);
            else XB_SPIN(xb_ld(&bar[XB_TOPGEN]) == tg, bar);
            __builtin_amdgcn_fence(__ATOMIC_ACQUIRE, "agent");
            xb_add(&bar[XB_XGEN(b.x)], 1u);
            asm volatile("s_waitcnt vmcnt(0)" ::: "memory");
        } else {
            XB_SPIN(xb_ld(&bar[XB_XGEN(b.x)]) == gen, bar);
            __builtin_amdgcn_fence(__ATOMIC_ACQUIRE, "agent");
            asm volatile("s_waitcnt vmcnt(0)" ::: "memory");
        }
    }
    __syncthreads();
}

namespace pg8 {
constexpr int BM = 256, BK = 64, HALF = 128, HTB = HALF * BK * 2, STAGE_BYTES = 8 * HTB, NXCD = 8, WGM = 8;
__host__ __device__ __forceinline__ int lds_byte(int r, int c) { const int st = (r >> 4) * 2 + (c >> 5), rr = r & 15, cc = c & 31, ob = rr * 64 + cc * 2; return st * 1024 + (ob ^ (((ob >> 9) & 1) << 5)); }
__host__ __device__ __forceinline__ void stage_rc(int b, int& R, int& C) { const int st = b / 1024, sb = b % 1024, swz = sb ^ (((sb >> 9) & 1) << 5); R = (st >> 1) * 16 + swz / 64; C = (st & 1) * 32 + (swz % 64) / 2; }
__host__ __device__ __forceinline__ int perm32(int rho) { const int n = rho >> 4, i = rho & 15; return 8 * (i >> 2) + 4 * n + (i & 3); }

struct Unit { const char* A; const char* B; int pm, pn, kind, nt; };

__device__ __forceinline__ void tile_order(int L, int nM, int nN, int& pm, int& pn) {
    const int nwg = nM * nN; int wgid = L;
    { const int q = nwg / NXCD, r = nwg % NXCD, xcd = wgid % NXCD, off = wgid / NXCD; wgid = (xcd < r ? xcd * (q + 1) : r * (q + 1) + (xcd - r) * q) + off; }
    const int nig = WGM * nN, gid = wgid / nig, fm = gid * WGM, gsz = (nM - fm) < WGM ? (nM - fm) : WGM;
    pm = fm + ((wgid % nig) % gsz); pn = (wgid % nig) / gsz;
}

template <class Epi, class Sched, bool ALIGN_EPI, bool SP2>
__device__ __forceinline__ void gemm_phase(LAS unsigned char* lds, const int pitchA, const int pitchB, const Sched& S, const Epi& E) {
    const int tid = fresh_tid(), wid = __builtin_amdgcn_readfirstlane(tid >> 6), lane = tid & 63, wr = wid >> 2, wc = wid & 3, fr = lane & 15, fq = lane >> 4;
    unsigned voffA[2], voffB[2];
#pragma unroll
    for (int i = 0; i < 2; ++i) { int R, C; stage_rc(tid * 16 + i * 8192, R, C); const int Rb = (R & ~31) + perm32(R & 31);
        voffA[i] = (unsigned)(R * pitchA + C) * 2u; voffB[i] = (unsigned)(Rb * pitchB + C) * 2u; }
    const size_t kstep = (size_t)(BK * 2);
    const size_t hstepA = (size_t)HALF * pitchA * 2, hstepB = (size_t)HALF * pitchB * 2;
    const unsigned ldsw = (unsigned)wid * 1024u;
    const int aoff = lds_byte(wr * 64 + fr, fq * 8), boff = lds_byte(wc * 32 + fr, fq * 8);
#define PG8_SA(b, h) (((b) * 2 + (h)) * HTB)
#define PG8_SB(b, h) ((4 + (b) * 2 + (h)) * HTB)
#define PG8_STAGE(bufoff, gbase, voff) do { _Pragma("unroll") for (int _i = 0; _i < 2; ++_i) \
        __builtin_amdgcn_global_load_lds((const unsigned*)((const char*)(gbase) + (voff)[_i]), (LAS unsigned*)(lds + (bufoff) + ldsw + _i * 8192), 16, 0, 0); } while (0)
#define PG8_LDA(dst, b, h) do { _Pragma("unroll") for (int m = 0; m < 4; ++m) _Pragma("unroll") for (int k = 0; k < 2; ++k) dst[m][k] = *(const LAS bf16x8*)(lds + PG8_SA(b, h) + aoff + m * 2048 + k * 1024); } while (0)
#define PG8_LDB(dst, b, h) do { _Pragma("unroll") for (int n = 0; n < 2; ++n) _Pragma("unroll") for (int k = 0; k < 2; ++k) dst[n][k] = *(const LAS bf16x8*)(lds + PG8_SB(b, h) + boff + n * 2048 + k * 1024); } while (0)
#define PG8_MMA(ai, bj, At, Bt) do { __builtin_amdgcn_s_setprio(1); _Pragma("unroll") for (int m = 0; m < 4; ++m) _Pragma("unroll") for (int n = 0; n < 2; ++n) _Pragma("unroll") for (int k = 0; k < 2; ++k) \
        acc[ai][bj][m][n] = __builtin_amdgcn_mfma_f32_16x16x32_bf16(Bt[n][k], At[m][k], acc[ai][bj][m][n], 0, 0, 0); __builtin_amdgcn_s_setprio(0); } while (0)
#define PG8_WAIT_V(n) asm volatile("s_waitcnt vmcnt(" #n ")" ::: "memory")
#define PG8_WAIT_L(n) asm volatile("s_waitcnt lgkmcnt(" #n ")" ::: "memory")
#define PG8_BAR __builtin_amdgcn_s_barrier()
#define PG8_SCHED __builtin_amdgcn_sched_barrier(0)
    Unit cur, nxt; int ui = 0;
    if (!S.next(0, cur)) return;
    f32x4 acc[2][2][4][2];
#pragma unroll
    for (int a = 0; a < 2; ++a)
#pragma unroll
        for (int b = 0; b < 2; ++b)
#pragma unroll
            for (int m = 0; m < 4; ++m)
#pragma unroll
                for (int n = 0; n < 2; ++n) acc[a][b][m][n] = (f32x4){0.f, 0.f, 0.f, 0.f};
    bf16x8 At[4][2], B0[2][2], B1[2][2];
    const char* cA = cur.A; const char* cB = cur.B;
    if constexpr (SP2) {
        PG8_STAGE(PG8_SB(0, 0), cB, voffB); PG8_STAGE(PG8_SB(0, 1), cB + hstepB, voffB); PG8_STAGE(PG8_SA(0, 0), cA, voffA); PG8_STAGE(PG8_SA(0, 1), cA + hstepA, voffA);
        if (wr == 1) PG8_BAR;
        PG8_WAIT_V(2); PG8_BAR;
        PG8_STAGE(PG8_SB(1, 0), cB + kstep, voffB); PG8_STAGE(PG8_SA(1, 0), cA + kstep, voffA); PG8_STAGE(PG8_SB(1, 1), cB + hstepB + kstep, voffB);
        PG8_WAIT_V(6); PG8_BAR;
    } else {
        PG8_STAGE(PG8_SB(0, 0), cB, voffB); PG8_STAGE(PG8_SA(0, 0), cA, voffA); PG8_STAGE(PG8_SB(0, 1), cB + hstepB, voffB); PG8_STAGE(PG8_SA(0, 1), cA + hstepA, voffA);
        if (wr == 1) PG8_BAR;
        PG8_WAIT_V(4); PG8_BAR;
        PG8_STAGE(PG8_SB(1, 0), cB + kstep, voffB); PG8_STAGE(PG8_SA(1, 0), cA + kstep, voffA); PG8_STAGE(PG8_SB(1, 1), cB + hstepB + kstep, voffB);
        PG8_WAIT_V(6); PG8_BAR;
    }
    for (;;) {
        const bool has_next = S.next(ui + 1, nxt);
        const char* nA = has_next ? nxt.A : cA; const char* nB = has_next ? nxt.B : cB;
        const int nt = cur.nt;
#pragma unroll 1
        for (int t = 0; t < nt; t += 2) {
            const bool last = (t == nt - 2);
            const char* a1 = cA + (size_t)(t + 1) * kstep;
            const char* a2 = last ? nA : cA + (size_t)(t + 2) * kstep; const char* b2 = last ? nB : cB + (size_t)(t + 2) * kstep;
            const char* a3 = a2 + kstep; const char* b3 = b2 + kstep;
            if constexpr (SP2) {
            PG8_LDB(B0, 0, 0); PG8_LDB(B1, 0, 1); PG8_SCHED; PG8_LDA(At, 0, 0); PG8_STAGE(PG8_SA(1, 1), a1 + hstepA, voffA);
            PG8_WAIT_V(8); PG8_WAIT_L(0); PG8_BAR; PG8_MMA(0, 0, At, B0); PG8_MMA(0, 1, At, B1); PG8_BAR; PG8_SCHED;
            PG8_LDA(At, 0, 1); PG8_STAGE(PG8_SB(0, 0), b2, voffB); PG8_STAGE(PG8_SB(0, 1), b2 + hstepB, voffB); PG8_STAGE(PG8_SA(0, 0), a2, voffA);
            PG8_WAIT_V(8); PG8_WAIT_L(0); PG8_BAR; PG8_MMA(1, 0, At, B0); PG8_MMA(1, 1, At, B1); PG8_BAR; PG8_SCHED;
            PG8_LDB(B0, 1, 0); PG8_LDB(B1, 1, 1); PG8_SCHED; PG8_LDA(At, 1, 0); PG8_STAGE(PG8_SA(0, 1), a2 + hstepA, voffA);
            PG8_WAIT_V(8); PG8_WAIT_L(0); PG8_BAR; PG8_MMA(0, 0, At, B0); PG8_MMA(0, 1, At, B1); PG8_BAR; PG8_SCHED;
            PG8_LDA(At, 1, 1); PG8_STAGE(PG8_SB(1, 0), b3, voffB); PG8_STAGE(PG8_SB(1, 1), b3 + hstepB, voffB); PG8_STAGE(PG8_SA(1, 0), a3, voffA);
            PG8_WAIT_V(8); PG8_WAIT_L(0); PG8_BAR; PG8_MMA(1, 0, At, B0); PG8_MMA(1, 1, At, B1); PG8_BAR; PG8_SCHED;
            } else {
            PG8_LDB(B0, 0, 0); PG8_SCHED; PG8_LDA(At, 0, 0); PG8_STAGE(PG8_SA(1, 1), a1 + hstepA, voffA);
            PG8_WAIT_L(8); PG8_BAR; PG8_WAIT_L(0); PG8_MMA(0, 0, At, B0); PG8_BAR; PG8_SCHED;
            PG8_LDB(B1, 0, 1); PG8_STAGE(PG8_SB(0, 0), b2, voffB);
            PG8_BAR; PG8_WAIT_L(0); PG8_MMA(0, 1, At, B1); PG8_BAR;
            PG8_LDA(At, 0, 1); PG8_STAGE(PG8_SA(0, 0), a2, voffA);
            PG8_BAR; PG8_WAIT_L(0); PG8_MMA(1, 0, At, B0); PG8_BAR; PG8_SCHED;
            PG8_STAGE(PG8_SB(0, 1), b2 + hstepB, voffB);
            PG8_WAIT_V(6); PG8_BAR; PG8_MMA(1, 1, At, B1); PG8_BAR;
            PG8_LDB(B0, 1, 0); PG8_SCHED; PG8_LDA(At, 1, 0); PG8_STAGE(PG8_SA(0, 1), a2 + hstepA, voffA);
            PG8_WAIT_L(8); PG8_BAR; PG8_WAIT_L(0); PG8_MMA(0, 0, At, B0); PG8_BAR; PG8_SCHED;
            PG8_LDB(B1, 1, 1); PG8_STAGE(PG8_SB(1, 0), b3, voffB);
            PG8_BAR; PG8_WAIT_L(0); PG8_MMA(0, 1, At, B1); PG8_BAR;
            PG8_LDA(At, 1, 1); PG8_STAGE(PG8_SA(1, 0), a3, voffA);
            PG8_BAR; PG8_WAIT_L(0); PG8_MMA(1, 0, At, B0); PG8_BAR; PG8_SCHED;
            PG8_STAGE(PG8_SB(1, 1), b3 + hstepB, voffB);
            PG8_WAIT_V(6); PG8_BAR; PG8_MMA(1, 1, At, B1); PG8_BAR;
            }
        }
        if constexpr (ALIGN_EPI) { if (wr == 0) PG8_BAR; }
        E(acc, cur, wr, wc, fr, fq);
        if (!has_next) break;
#pragma unroll
        for (int a = 0; a < 2; ++a)
#pragma unroll
            for (int b = 0; b < 2; ++b)
#pragma unroll
                for (int m = 0; m < 4; ++m)
#pragma unroll
                    for (int n = 0; n < 2; ++n) acc[a][b][m][n] = (f32x4){0.f, 0.f, 0.f, 0.f};
        cur = nxt; cA = nA; cB = nB; ++ui;
        if constexpr (ALIGN_EPI) { if (wr == 1) PG8_BAR; }
    }
    PG8_WAIT_V(0);
    if constexpr (!ALIGN_EPI) { if (wr == 0) PG8_BAR; }
    PG8_BAR;
#undef PG8_SA
#undef PG8_SB
#undef PG8_STAGE
#undef PG8_LDA
#undef PG8_LDB
#undef PG8_MMA
#undef PG8_WAIT_V
#undef PG8_WAIT_L
#undef PG8_BAR
#undef PG8_SCHED
}
}
using pg8::Unit;

struct Args { const float* in[21]; float* out; unsigned char* ws; };
struct Frame {
    LAS unsigned char* lds;
    int tid, lane, wave, vcu, G;
    const float* in[21]; float* out; unsigned char* ws;
};
typedef const __attribute__((address_space(4))) Args KArgs;
__device__ __forceinline__ Frame make_frame(LAS unsigned char* lds) {
    Frame F; F.lds = lds;
    F.tid = fresh_tid(); F.lane = F.tid & 63; F.wave = __builtin_amdgcn_readfirstlane(F.tid >> 6);
    F.G = gridDim.x; { const int bx = blockIdx.x; F.vcu = (F.G % 8 == 0) ? (bx % 8) * (F.G / 8) + bx / 8 : bx; }
    KArgs* ka = (KArgs*)__builtin_amdgcn_kernarg_segment_ptr(); asm volatile("" : "+s"(ka));
#pragma unroll
    for (int i = 0; i < 21; ++i) F.in[i] = ka->in[i];
    F.out = ka->out; F.ws = ka->ws;
    return F;
}
#define WSP(T, off) ((T*)(F.ws + (off)))

__device__ __forceinline__ void p0_transpose_item(const float* Wsrc  , int ldw, bf16_t* dst  , int ldt, LAS float* scr, int lane) {
    const int r = lane >> 4, c4 = lane & 15;
    f32x4 v[16];
#pragma unroll
    for (int i = 0; i < 16; ++i) v[i] = __builtin_nontemporal_load((const GAS f32x4*)(Wsrc + (size_t)(4 * i + r) * ldw + 4 * c4));
#pragma unroll
    for (int i = 0; i < 16; ++i) { LAS float* s = scr + (4 * i + r) * 65 + 4 * c4; s[0] = v[i].x; s[1] = v[i].y; s[2] = v[i].z; s[3] = v[i].w; }
    LDS_WAIT(); asm volatile("" ::: "memory");
    const int c = lane & 7;
#pragma unroll
    for (int j = 0; j < 8; ++j) { const int n = (lane >> 3) + 8 * j; const LAS float* s = scr + (8 * c) * 65 + n;
        u32x4 o; o.x = cvt_pk_bf16(s[0 * 65], s[1 * 65]); o.y = cvt_pk_bf16(s[2 * 65], s[3 * 65]); o.z = cvt_pk_bf16(s[4 * 65], s[5 * 65]); o.w = cvt_pk_bf16(s[6 * 65], s[7 * 65]);
        *(GAS u32x4*)(dst + (size_t)n * ldt + 8 * c) = o; }
    LDS_WAIT(); asm volatile("" ::: "memory");
}
__device__ __forceinline__ void rms_row_to_bf16(const float* xrow, const float* g, bf16_t* orow, int lane) {
    const GAS f32x4* xr = (const GAS f32x4*)xrow + lane;
    f32x4 v[16], gv[16]; float s = 0.f;
    const GAS f32x4* gr = (const GAS f32x4*)g + lane;
#pragma unroll
    for (int j = 0; j < 16; ++j) v[j] = __builtin_nontemporal_load(xr + 64 * j);
#pragma unroll
    for (int j = 0; j < 16; ++j) gv[j] = gr[64 * j];
#pragma unroll
    for (int j = 0; j < 16; ++j) s += (v[j].x * v[j].x + v[j].y * v[j].y) + (v[j].z * v[j].z + v[j].w * v[j].w);
    const float rstd = 1.0f / sqrtf(wave_sum(s) * (1.0f / DM) + EPS);
    GAS u32x2* o8 = (GAS u32x2*)orow + lane;
#pragma unroll
    for (int j = 0; j < 16; ++j) { const f32x4 gg = gv[j]; u32x2 w; w.x = cvt_pk_bf16(v[j].x * rstd * gg.x, v[j].y * rstd * gg.y); w.y = cvt_pk_bf16(v[j].z * rstd * gg.z, v[j].w * rstd * gg.w); o8[64 * j] = w; }
}
__device__ __forceinline__ int win_src_col(int np) { const int t = np >> 8, i = np & 255; return (t >= 12 && t < 24) ? ((i < 128) ? 3072 + 128 * (t - 12) + i : 4608 + 128 * (t - 12) + (i - 128)) : np; }

constexpr int I_IN = 64 * 152, I_KV = 64 * 16, I_OUT = 64 * 64, I_PW = 24 * 24, I_PL = 6 * 6;
constexpr int NITEMS_EARLY = I_IN + 2 * I_KV, NITEMS = NITEMS_EARLY + I_OUT + I_PW + 4 * I_PL;
__device__ __forceinline__ void p0_items(Frame& F, int first, int last, int gw, int NGW) {
    LAS float* scr = (LAS float*)(F.lds + F.wave * 16640);
    bf16_t* WIN = WSP(bf16_t, WS_WIN); bf16_t* WKV = WSP(bf16_t, WS_WKV); bf16_t* WOUT = WSP(bf16_t, WS_WOUT); bf16_t* WPW = WSP(bf16_t, WS_WPW); bf16_t* WPOOL = WSP(bf16_t, WS_WPOOL);
    for (int it = first + gw; it < last; it += NGW) {
        int r = it; const float* src; bf16_t* dst; int ldw, ldt;
        if (r < I_IN) { const int kb = r / 152, nb = r % 152; src = F.in[9] + (size_t)(64 * kb) * DIN + win_src_col(64 * nb); ldw = DIN; dst = WIN + (size_t)(64 * nb) * DM + 64 * kb; ldt = DM; }
        else if ((r -= I_IN) < I_KV) { const int kb = r / 16, nb = r % 16; src = F.in[10] + (size_t)(64 * kb) * DX + 64 * nb; ldw = DX; dst = WKV + (size_t)(64 * nb) * DM + 64 * kb; ldt = DM; }
        else if ((r -= I_KV) < I_KV) { const int kb = r / 16, nb = r % 16; src = F.in[11] + (size_t)(64 * kb) * DX + 64 * nb; ldw = DX; dst = WKV + (size_t)(1024 + 64 * nb) * DM + 64 * kb; ldt = DM; }
        else if ((r -= I_KV) < I_OUT) { const int kb = r / 64, nb = r % 64; src = F.in[19] + (size_t)(64 * kb) * DM + 64 * nb; ldw = DM; dst = WOUT + (size_t)(64 * nb) * DM + 64 * kb; ldt = DM; }
        else if ((r -= I_OUT) < I_PW) { const int kb = r / 24, nb = r % 24; src = F.in[18] + (size_t)(64 * kb) * DCONV + 64 * nb; ldw = DCONV; dst = WPW + (size_t)(64 * nb) * DCONV + 64 * kb; ldt = DCONV; }
        else { r -= I_PW; const int g = r / I_PL, q = r % I_PL, kb = q / 6, nb = q % 6;
            src = F.in[12] + (size_t)g * PGRP * PGRP + (size_t)(64 * kb) * PGRP + 64 * nb; ldw = PGRP; dst = WPOOL + (size_t)g * 512 * PGRP + (size_t)(64 * nb) * PGRP + 64 * kb; ldt = PGRP; }
        p0_transpose_item(src, ldw, dst, ldt, scr, F.lane);
    }
}
__device__ __forceinline__ void p0_pool_pad(Frame& F, int gt, int NGT) {
    bf16_t* WPOOL = WSP(bf16_t, WS_WPOOL);
    for (int i = gt; i < 4 * 6144; i += NGT) { const int g = i / 6144, q = i % 6144; *(GAS u32x4*)(WPOOL + (size_t)g * 512 * PGRP + (size_t)384 * PGRP + (size_t)q * 8) = (u32x4){0u, 0u, 0u, 0u}; }
}
__device__ __forceinline__ void p0_pool_frag(Frame& F, int gt, int NGT) {
    bf16_t* WF = WSP(bf16_t, WS_WPOOLF);
    for (int i = gt; i < 4 * 24 * 12 * 64; i += NGT) { const int l = i & 63, blk = i >> 6, ks = blk % 12, nt = (blk / 12) % 24, g = blk / 288;
        const float* src = F.in[12] + (size_t)g * PGRP * PGRP + (size_t)(32 * ks + 8 * (l >> 4)) * PGRP + 16 * nt + (l & 15);
        float v[8];
#pragma unroll
        for (int e = 0; e < 8; ++e) v[e] = *(const GAS float*)(src + (size_t)e * PGRP);
        *(GAS u32x4*)(WF + (size_t)i * 8) = (u32x4){cvt_pk_bf16(v[0], v[1]), cvt_pk_bf16(v[2], v[3]), cvt_pk_bf16(v[4], v[5]), cvt_pk_bf16(v[6], v[7])}; }
}
__device__ __forceinline__ void p0_prologue(Frame& F, bool all_weights) {
    const int gw = F.vcu * NWAVES + F.wave, NGW = F.G * NWAVES;
    p0_items(F, 0, all_weights ? NITEMS : NITEMS_EARLY, gw, NGW);
    if (all_weights) { p0_pool_pad(F, F.vcu * NTHR + F.tid, F.G * NTHR); p0_pool_frag(F, F.vcu * NTHR + F.tid, F.G * NTHR); }
    bf16_t* H = WSP(bf16_t, WS_H); bf16_t* HM = WSP(bf16_t, WS_HM);
    for (int m = gw; m < MT + MM; m += NGW) {
        if (m < MP) rms_row_to_bf16(F.in[0] + (size_t)m * DM, F.in[7], H + (size_t)m * DM, F.lane);
        else if (m < MT) rms_row_to_bf16(F.in[2] + (size_t)(m - MP) * DM, F.in[7], H + (size_t)m * DM, F.lane);
        else rms_row_to_bf16(F.in[1] + (size_t)(m - MT) * DM, F.in[8], HM + (size_t)(m - MT) * DM, F.lane);
    }
}

constexpr int G1_NM = MT / 256, G1_NN = DIN / 256, G1_IN = G1_NM * G1_NN, G1_ALL = G1_IN + 48;
constexpr size_t TSTEP4K = (size_t)256 * DM * 2;
constexpr int G1_SPECIAL = 16, G1_PROMPT = (MP / 256) * G1_NN, G1_S2 = 60;
struct Sched1 {
    int G, c; const char *H, *HM, *WIN, *WKV;
    __device__ __forceinline__ bool next(int i, Unit& u) const {
        int L = i * G + c; if (L >= G1_ALL) return false;
        u.nt = DM / 64; u.kind = 0;
        if (L < G1_SPECIAL) { u.pm = MP / 256 + (L >> 3); u.pn = 30 + (L & 7); u.kind = 4; }
        else if ((L -= G1_SPECIAL) < G1_PROMPT) { int pm, pn; pg8::tile_order(L, MP / 256, G1_NN, pm, pn); u.pm = pm; u.pn = pn; }
        else if ((L -= G1_PROMPT) < G1_S2) { u.pm = MP / 256 + L / 30; u.pn = L % 30; }
        else { const int r = L - G1_S2, t = r >> 4, pm = (r >> 2) & 3, pn = r & 3; u.pm = pm; u.pn = pn; u.kind = 1 + t;
            if (t == 0) { u.A = HM + (size_t)pm * TSTEP4K; u.B = WKV + (size_t)pn * TSTEP4K; }
            else if (t == 1) { u.A = HM + (size_t)pm * TSTEP4K; u.B = WKV + (size_t)(4 + pn) * TSTEP4K; }
            else { u.A = WKV + (size_t)(4 + pm) * TSTEP4K; u.B = HM + (size_t)pn * TSTEP4K; }
            return true; }
        u.A = H + (size_t)u.pm * TSTEP4K; u.B = WIN + (size_t)u.pn * TSTEP4K;
        return true;
    }
};
struct Epi1 {
    bf16_t *U, *SGA, *A, *SGB, *Q, *SGC, *KP, *VPT; float *outK, *outV; unsigned* qready;
    __device__ __forceinline__ void operator()(const f32x4 (&acc)[2][2][4][2], const Unit& u, int wr, int wc, int fr, int fq) const {
        const int row0 = u.pm * 256 + wr * 64 + fr, cl = wc * 32 + 8 * fq;
        if (u.kind == 0 || u.kind == 4) {
            const int pn = u.pn;
            if (pn >= 12 && pn < 24) {
                bf16_t* base = A + (size_t)row0 * DCONV + (pn - 12) * 128 + cl;
#pragma unroll
                for (int ai = 0; ai < 2; ++ai)
#pragma unroll
                    for (int m = 0; m < 4; ++m) { const f32x4 v0 = acc[ai][0][m][0], v1 = acc[ai][0][m][1], g0 = acc[ai][1][m][0], g1 = acc[ai][1][m][1];
                        u32x4 w; w.x = cvt_pk_bf16(v0[0] * fast_sigmoid(g0[0]), v0[1] * fast_sigmoid(g0[1])); w.y = cvt_pk_bf16(v0[2] * fast_sigmoid(g0[2]), v0[3] * fast_sigmoid(g0[3]));
                        w.z = cvt_pk_bf16(v1[0] * fast_sigmoid(g1[0]), v1[1] * fast_sigmoid(g1[1])); w.w = cvt_pk_bf16(v1[2] * fast_sigmoid(g1[2]), v1[3] * fast_sigmoid(g1[3]));
                        *(u32x4*)(base + (size_t)(ai * 128 + m * 16) * DCONV) = w; }
            } else {
                bf16_t* dst; int ldc, colt; bool act;
                if (pn < 6) { dst = U; ldc = DPOOL; colt = pn * 256; act = false; }
                else if (pn < 12) { dst = SGA; ldc = DPOOL; colt = (pn - 6) * 256; act = true; }
                else if (pn < 30) { dst = SGB; ldc = DCONV; colt = (pn - 24) * 256; act = true; }
                else if (pn < 34) { dst = Q; ldc = DX; colt = (pn - 30) * 256; act = false; }
                else { dst = SGC; ldc = DX; colt = (pn - 34) * 256; act = true; }
                bf16_t* base = dst + (size_t)row0 * ldc + colt + cl;
#pragma unroll
                for (int ai = 0; ai < 2; ++ai)
#pragma unroll
                    for (int m = 0; m < 4; ++m)
#pragma unroll
                        for (int bj = 0; bj < 2; ++bj) { f32x4 v0 = acc[ai][bj][m][0], v1 = acc[ai][bj][m][1];
                            if (act) {
#pragma unroll
                                for (int j = 0; j < 4; ++j) { v0[j] = fast_silu(v0[j]); v1[j] = fast_silu(v1[j]); } }
                            u32x4 w; w.x = cvt_pk_bf16(v0[0], v0[1]); w.y = cvt_pk_bf16(v0[2], v0[3]); w.z = cvt_pk_bf16(v1[0], v1[1]); w.w = cvt_pk_bf16(v1[2], v1[3]);
                            *(u32x4*)(base + (size_t)(ai * 128 + m * 16) * ldc + bj * 128) = w; }
            }
        } else if (u.kind == 3) {
            bf16_t* base = VPT + (size_t)row0 * 1024 + u.pn * 256 + cl;
#pragma unroll
            for (int ai = 0; ai < 2; ++ai)
#pragma unroll
                for (int m = 0; m < 4; ++m)
#pragma unroll
                    for (int bj = 0; bj < 2; ++bj) { const f32x4 v0 = acc[ai][bj][m][0], v1 = acc[ai][bj][m][1];
                        u32x4 w; w.x = cvt_pk_bf16(v0[0], v0[1]); w.y = cvt_pk_bf16(v0[2], v0[3]); w.z = cvt_pk_bf16(v1[0], v1[1]); w.w = cvt_pk_bf16(v1[2], v1[3]);
                        *(u32x4*)(base + (size_t)(ai * 128 + m * 16) * 1024 + bj * 128) = w; }
        } else {
            float* fb = (u.kind == 1 ? outK : outV) + (size_t)row0 * 1024 + u.pn * 256 + cl;
            bf16_t* kb = KP + (size_t)row0 * 1024 + u.pn * 256 + cl;
            const bool wk = (u.kind == 1);
#pragma unroll
            for (int ai = 0; ai < 2; ++ai)
#pragma unroll
                for (int m = 0; m < 4; ++m)
#pragma unroll
                    for (int bj = 0; bj < 2; ++bj) { const f32x4 v0 = acc[ai][bj][m][0], v1 = acc[ai][bj][m][1];
                        float* p = fb + (size_t)(ai * 128 + m * 16) * 1024 + bj * 128; *(f32x4*)p = v0; *(f32x4*)(p + 4) = v1;
                        if (wk) { u32x4 w; w.x = cvt_pk_bf16(v0[0], v0[1]); w.y = cvt_pk_bf16(v0[2], v0[3]); w.z = cvt_pk_bf16(v1[0], v1[1]); w.w = cvt_pk_bf16(v1[2], v1[3]);
                            *(u32x4*)(kb + (size_t)(ai * 128 + m * 16) * 1024 + bj * 128) = w; } }
        }
        if (u.kind == 4) {
            asm volatile("s_waitcnt vmcnt(0)" ::: "memory"); __builtin_amdgcn_s_barrier(); asm volatile("" ::: "memory");
            if (threadIdx.x == 0) { __builtin_amdgcn_fence(__ATOMIC_RELEASE, "agent"); asm volatile("s_waitcnt vmcnt(0)" ::: "memory");
                __hip_atomic_fetch_add(qready, 1u, __ATOMIC_RELAXED, __HIP_MEMORY_SCOPE_AGENT); } }
    }
};

__device__ __forceinline__ f32x4 ld_bf4(const bf16_t* p) { const u32x2 w = *(const GAS u32x2*)p; return (f32x4){bf_lo(w.x), bf_hi(w.x), bf_lo(w.y), bf_hi(w.y)}; }
__device__ __forceinline__ void states_copy_rows(Frame& F, int gw, int NGW) {
    constexpr int KP_ = PSTATE - DS, KC_ = CSTATE - DS, R_P = DB * KP_, R_C = DB * KC_;
    const unsigned ln = (unsigned)F.lane;
    for (int i = gw; i < R_P + R_C; i += NGW) {
        const float* sf; float* dst;
        if (i < R_P) { const int b = i / KP_, j = i % KP_; sf = F.in[5] + (size_t)(b * PSTATE + j + DS) * DPOOL; dst = F.out + O_PSS + (size_t)(b * PSTATE + j) * DPOOL; }
        else { const int r = i - R_P, b = r / KC_, j = r % KC_; sf = F.in[6] + (size_t)(b * CSTATE + j + DS) * DCONV; dst = F.out + O_CSS + (size_t)(b * CSTATE + j) * DCONV; }
        f32x4 v[6];
#pragma unroll
        for (int k = 0; k < 6; ++k) v[k] = ldg<f32x4>(sf, (256u * k + 4u * ln) * 4u);
#pragma unroll
        for (int k = 0; k < 6; ++k) *(GAS f32x4*)((char*)dst + (256u * k + 4u * ln) * 4u) = v[k];
    }
}
__device__ __forceinline__ void p2_states(Frame& F) {
    const bf16_t* U = WSP(bf16_t, WS_U); const bf16_t* A = WSP(bf16_t, WS_A);
    constexpr int R_PSP = NB * PSTATE, R_CSP = NB * CSTATE, R_S = DB * DS;
    const unsigned ln = (unsigned)F.lane;
    for (int i = F.vcu * NWAVES + F.wave; i < R_PSP + R_CSP + 2 * R_S; i += F.G * NWAVES) {
        int r = i; const bf16_t* sb; float* dst;
        if (r < R_PSP) { const int j = r % PSTATE, b = r / PSTATE; sb = U + (size_t)(b * SEQ + SEQ - PSTATE + j) * DPOOL; dst = F.out + O_PSP + (size_t)r * DPOOL; }
        else if ((r -= R_PSP) < R_CSP) { const int j = r % CSTATE, b = r / CSTATE; sb = A + (size_t)(b * SEQ + SEQ - CSTATE + j) * DCONV; dst = F.out + O_CSP + (size_t)r * DCONV; }
        else if ((r -= R_CSP) < R_S) { const int b = r >> 2, t = r & 3; sb = U + (size_t)(MP + r) * DPOOL; dst = F.out + O_PSS + (size_t)(b * PSTATE + PSTATE - DS + t) * DPOOL; }
        else { r -= R_S; const int b = r >> 2, t = r & 3; sb = A + (size_t)(MP + r) * DCONV; dst = F.out + O_CSS + (size_t)(b * CSTATE + CSTATE - DS + t) * DCONV; }
        f32x4 v[6];
#pragma unroll
        for (int k = 0; k < 6; ++k) { const u32x2 w = ldg<u32x2>(sb, (256u * k + 4u * ln) * 2u); v[k] = (f32x4){bf_lo(w.x), bf_hi(w.x), bf_lo(w.y), bf_hi(w.y)}; }
#pragma unroll
        for (int k = 0; k < 6; ++k) *(GAS f32x4*)((char*)dst + (256u * k + 4u * ln) * 4u) = v[k];
    }
}
template <int W, bool SAMPLE> __device__ __forceinline__ void pool_task(Frame& F, int r0  , int c  , size_t src_off = WS_U, size_t dst_off = WS_POOLED) {
    const bf16_t* U = WSP(bf16_t, src_off); bf16_t* P = WSP(bf16_t, dst_off);
    constexpr bool sample = SAMPLE;
    const int pos0 = sample ? 0 : (r0 & (SEQ - 1));
    const int bs = (r0 - MP) >> 2;
    float x[W + 3][8];
#pragma unroll
    for (int i = 0; i < W + 3; ++i) {
        const int rr = i - (W - 1);
        if (rr >= 0 || (!sample && pos0 + rr >= 0)) { const u32x4 w = *(const GAS u32x4*)(U + (size_t)(r0 + rr) * DPOOL + c);
            x[i][0] = bf_lo(w.x); x[i][1] = bf_hi(w.x); x[i][2] = bf_lo(w.y); x[i][3] = bf_hi(w.y); x[i][4] = bf_lo(w.z); x[i][5] = bf_hi(w.z); x[i][6] = bf_lo(w.w); x[i][7] = bf_hi(w.w); }
        else if (sample) { const float* sp = F.in[5] + ((size_t)bs * PSTATE + (PSTATE + rr)) * DPOOL + c; const f32x4 a = *(const GAS f32x4*)sp, b = *(const GAS f32x4*)(sp + 4);
            x[i][0] = a.x; x[i][1] = a.y; x[i][2] = a.z; x[i][3] = a.w; x[i][4] = b.x; x[i][5] = b.y; x[i][6] = b.z; x[i][7] = b.w; }
        else {
#pragma unroll
            for (int e = 0; e < 8; ++e) x[i][e] = 0.f; }
    }
#pragma unroll
    for (int tk = 0; tk < 4; ++tk) {
        float s[8];
#pragma unroll
        for (int e = 0; e < 8; ++e) s[e] = 0.f;
#pragma unroll
        for (int i = 0; i < W; ++i)
#pragma unroll
            for (int e = 0; e < 8; ++e) s[e] += x[tk + i][e];
        const int pos = pos0 + tk; const float inv = sample ? (1.0f / W) : 1.0f / (float)((pos + 1 < W) ? pos + 1 : W);
        u32x4 o; o.x = cvt_pk_bf16(s[0] * inv - x[tk + W - 1][0], s[1] * inv - x[tk + W - 1][1]); o.y = cvt_pk_bf16(s[2] * inv - x[tk + W - 1][2], s[3] * inv - x[tk + W - 1][3]);
        o.z = cvt_pk_bf16(s[4] * inv - x[tk + W - 1][4], s[5] * inv - x[tk + W - 1][5]); o.w = cvt_pk_bf16(s[6] * inv - x[tk + W - 1][6], s[7] * inv - x[tk + W - 1][7]);
        *(GAS u32x4*)(P + (size_t)(r0 + tk) * DPOOL + c) = o;
    }
}
__device__ __forceinline__ void p2_pool_sample_task(Frame& F, int sidx) {
    const int R0 = (256 + sidx / 24) * 32, id = sidx % 24, g = id / 6, q = id % 6, third = q >> 1, half = q & 1;
    const int r0 = R0 + 16 * half + 4 * (F.lane >> 4), c = g * PGRP + third * 128 + (F.lane & 15) * 8;
    if (g == 0) pool_task<2, true>(F, r0, c); else if (g == 1) pool_task<4, true>(F, r0, c); else if (g == 2) pool_task<8, true>(F, r0, c); else pool_task<16, true>(F, r0, c);
}
constexpr int PL_ROWS = 32 + PSTATE, PL_STAGE = PL_ROWS * DPOOL * 2;
__device__ __forceinline__ void lds_row8(const LAS unsigned char* p, float (&x)[8]) { const u32x4 w = *(const LAS u32x4*)p;
    x[0] = bf_lo(w.x); x[1] = bf_hi(w.x); x[2] = bf_lo(w.y); x[3] = bf_hi(w.y); x[4] = bf_lo(w.z); x[5] = bf_hi(w.z); x[6] = bf_lo(w.w); x[7] = bf_hi(w.w); }
__device__ __forceinline__ void p2_pool_unit_prompt(Frame& F, int unit, int sidx = -1) {
    LAS unsigned char* S = F.lds;
    const bf16_t* U = WSP(bf16_t, WS_U); bf16_t* P = WSP(bf16_t, WS_POOLED);
    unsigned tid = (unsigned)F.tid; asm volatile("" : "+v"(tid));
    const unsigned ln = tid & 63u;
    const int R0 = unit * 32, pos_u = (unit & 63) * 32;
#pragma unroll 1
    for (int i = F.wave; i < PL_ROWS * 3; i += NWAVES) { const int row = i / 3, th = i - 3 * row, rel = row - PSTATE;
        if (pos_u + rel >= 0) __builtin_amdgcn_global_load_lds((const unsigned*)((const char*)(U + (size_t)(R0 + rel) * DPOOL) + th * 1024 + ln * 16u), (LAS unsigned*)(S + i * 1024), 16, 0, 0);
        else *(LAS u32x4*)(S + i * 1024 + ln * 16u) = (u32x4){0u, 0u, 0u, 0u}; }
    if (sidx >= 0 && sidx < 16 * 24) p2_pool_sample_task(F, sidx);
    asm volatile("s_waitcnt vmcnt(0) lgkmcnt(0)" ::: "memory"); __syncthreads();
#pragma unroll 1
    for (int k = 0; k < 3; ++k) { const unsigned id = tid + 512u * k, co = id % 192u, tg = id / 192u, g = co / 48u; const int W = 2 << g;
        const LAS unsigned char* base = S + co * 16u + (PSTATE + 4 * tg) * (DPOOL * 2);
        float s[8], x[8];
#pragma unroll
        for (int e = 0; e < 8; ++e) s[e] = 0.f;
        for (int i = 0; i < W; ++i) { lds_row8(base - i * (DPOOL * 2), x);
#pragma unroll
            for (int e = 0; e < 8; ++e) s[e] += x[e]; }
#pragma unroll
        for (int tk = 0; tk < 4; ++tk) {
            if (tk > 0) { float a[8], b[8]; lds_row8(base + tk * (DPOOL * 2), a); lds_row8(base + (tk - W) * (DPOOL * 2), b);
#pragma unroll
                for (int e = 0; e < 8; ++e) s[e] += a[e] - b[e]; }
            lds_row8(base + tk * (DPOOL * 2), x);
            const int pos = pos_u + 4 * (int)tg + tk; const float inv = 1.0f / (float)((pos + 1 < W) ? pos + 1 : W);
            u32x4 o; o.x = cvt_pk_bf16(s[0] * inv - x[0], s[1] * inv - x[1]); o.y = cvt_pk_bf16(s[2] * inv - x[2], s[3] * inv - x[3]);
            o.z = cvt_pk_bf16(s[4] * inv - x[4], s[5] * inv - x[5]); o.w = cvt_pk_bf16(s[6] * inv - x[6], s[7] * inv - x[7]);
            *(GAS u32x4*)((char*)(P + (size_t)(R0 + 4 * tg + tk) * DPOOL) + co * 16u) = o; }
    }
    LDS_WAIT(); __syncthreads();
}
constexpr int PM_ROWS = 128 + PSTATE, PM_PITCH = 1024, PM_PLP = 784;
__device__ __forceinline__ void p2_poolmix_unit(Frame& F, int unit) {
    LAS unsigned char* S = F.lds;
    const bf16_t* U = WSP(bf16_t, WS_U); const bf16_t* WF = WSP(bf16_t, WS_WPOOLF); const bf16_t* SGA = WSP(bf16_t, WS_SGA); bf16_t* CAT = WSP(bf16_t, WS_CAT);
    const int g = unit & 3, rb = unit >> 2, R0 = rb * 128, pos_u = (rb & 15) * 128;
    unsigned tid = (unsigned)F.tid; asm volatile("" : "+v"(tid));
    const unsigned ln = tid & 63u, fr = ln & 15u, fq = ln >> 4;
#pragma unroll 1
    for (int row = F.wave; row < PM_ROWS; row += NWAVES) { const int rel = row - PSTATE;
        if (pos_u + rel >= 0) __builtin_amdgcn_global_load_lds((const unsigned*)((const char*)(U + (size_t)(R0 + rel) * DPOOL + g * PGRP) + ln * 16u), (LAS unsigned*)(S + row * PM_PITCH), 16, 0, 0);
        else { unsigned zz = 0u; asm volatile("" : "+v"(zz)); *(LAS u32x4*)(S + row * PM_PITCH + ln * 16u) = (u32x4){zz, zz, zz, zz}; } }
    const int n0 = 48 * F.wave;
    constexpr int NKS = PGRP / 32, DEPTH = 3, PM_PO = PGRP * 4 + 16;
    const bf16_t* wb = WF + (size_t)((g * 24 + 3 * F.wave) * NKS) * 512;
    const unsigned woff = ln * 16u;
    bf16x8 bq[DEPTH][3]; u32x4 gts[6]; f32x4 ps[3];
#pragma unroll
    for (int d = 0; d < DEPTH; ++d)
#pragma unroll
        for (int j = 0; j < 3; ++j) bq[d][j] = ldg<bf16x8>(wb + (size_t)(j * NKS + d) * 512, woff);
    asm volatile("s_waitcnt vmcnt(0) lgkmcnt(0)" ::: "memory"); __syncthreads();
    const int W = 2 << g;
    u32x4 pv[3][4];
#pragma unroll
    for (int k = 0; k < 3; ++k) { const unsigned id = tid + 512u * k, co = id % 48u, tg = id / 48u;
        const LAS unsigned char* base = S + co * 16u + (PSTATE + 4 * tg) * PM_PITCH;
        float s[8], x[8];
#pragma unroll
        for (int e = 0; e < 8; ++e) s[e] = 0.f;
        for (int i = 0; i < W; ++i) { lds_row8(base - i * PM_PITCH, x);
#pragma unroll
            for (int e = 0; e < 8; ++e) s[e] += x[e]; }
#pragma unroll
        for (int tk = 0; tk < 4; ++tk) {
            if (tk > 0) { float a[8], b[8]; lds_row8(base + tk * PM_PITCH, a); lds_row8(base + (tk - W) * PM_PITCH, b);
#pragma unroll
                for (int e = 0; e < 8; ++e) s[e] += a[e] - b[e]; }
            lds_row8(base + tk * PM_PITCH, x);
            const int pos = pos_u + 4 * (int)tg + tk; const float inv = 1.0f / (float)((pos + 1 < W) ? pos + 1 : W);
            u32x4 o; o.x = cvt_pk_bf16(s[0] * inv - x[0], s[1] * inv - x[1]); o.y = cvt_pk_bf16(s[2] * inv - x[2], s[3] * inv - x[3]);
            o.z = cvt_pk_bf16(s[4] * inv - x[4], s[5] * inv - x[5]); o.w = cvt_pk_bf16(s[6] * inv - x[6], s[7] * inv - x[7]);
            pv[k][tk] = o; }
    }
    LDS_WAIT(); __syncthreads();
#pragma unroll
    for (int k = 0; k < 3; ++k) { const unsigned id = tid + 512u * k, co = id % 48u, tg = id / 48u;
#pragma unroll
        for (int tk = 0; tk < 4; ++tk) *(LAS u32x4*)(S + (4 * tg + tk) * PM_PLP + co * 16u) = pv[k][tk]; }
    LDS_WAIT(); __syncthreads();
    f32x4 acc[8][3];
#pragma unroll
    for (int mi = 0; mi < 8; ++mi)
#pragma unroll
        for (int j = 0; j < 3; ++j) acc[mi][j] = (f32x4){0.f, 0.f, 0.f, 0.f};
#pragma unroll
    for (int j = 0; j < 3; ++j) ps[j] = ldg<f32x4>(F.in[13], ((unsigned)(g * PGRP + n0 + 16 * j) + 4u * fq) * 4u);
    const LAS unsigned char* ap = S + fr * PM_PLP + fq * 16u;
    bf16x8 an[4];
#pragma unroll
    for (int m = 0; m < 4; ++m) an[m] = *(const LAS bf16x8*)(ap + (16 * m) * PM_PLP);
#pragma unroll
    for (int ks = 0; ks < NKS; ++ks) {
        bf16x8 bc[3];
#pragma unroll
        for (int j = 0; j < 3; ++j) bc[j] = bq[ks % DEPTH][j];
        if (ks + DEPTH < NKS) {
#pragma unroll
            for (int j = 0; j < 3; ++j) bq[ks % DEPTH][j] = ldg<bf16x8>(wb + (size_t)(j * NKS + ks + DEPTH) * 512, woff); }
#pragma unroll
        for (int h = 0; h < 2; ++h) { bf16x8 a[4];
#pragma unroll
            for (int m = 0; m < 4; ++m) a[m] = an[m];
            const int hn = (h + 1) & 1, kn = ks + (h == 1 ? 1 : 0);
            if (kn < NKS) {
#pragma unroll
                for (int m = 0; m < 4; ++m) an[m] = *(const LAS bf16x8*)(ap + (16 * (4 * hn + m)) * PM_PLP + 64 * kn); }
#pragma unroll
            for (int m = 0; m < 4; ++m)
#pragma unroll
                for (int j = 0; j < 3; ++j) acc[4 * h + m][j] = __builtin_amdgcn_mfma_f32_16x16x32_bf16(bc[j], a[m], acc[4 * h + m][j], 0, 0, 0); }
    }
    unsigned t2 = tid; asm volatile("" : "+v"(t2));
#pragma unroll
    for (int h = 0; h < 2; ++h) {
#pragma unroll
        for (int k = 0; k < 6; ++k) { const unsigned id = t2 + 512u * k, row = id / 48u, c8 = id % 48u;
            gts[k] = ldg<u32x4>(SGA + (size_t)(R0 + 64 * h) * DPOOL + g * PGRP, (row * (unsigned)DPOOL + 8u * c8) * 2u); }
        LDS_WAIT(); __syncthreads();
#pragma unroll
        for (int m = 0; m < 4; ++m)
#pragma unroll
            for (int j = 0; j < 3; ++j) *(LAS f32x4*)(S + (16 * m + fr) * PM_PO + (n0 + 16 * j + 4 * fq) * 4) = acc[4 * h + m][j] * ps[j];
        LDS_WAIT(); __syncthreads();
#pragma unroll
        for (int k = 0; k < 6; ++k) { const unsigned id = t2 + 512u * k, row = id / 48u, c8 = id % 48u;
            const f32x4 v0 = *(const LAS f32x4*)(S + row * PM_PO + c8 * 32u), v1 = *(const LAS f32x4*)(S + row * PM_PO + c8 * 32u + 16u); const u32x4 gg = gts[k];
            u32x4 w; w.x = cvt_pk_bf16(v0[0] * bf_lo(gg.x), v0[1] * bf_hi(gg.x)); w.y = cvt_pk_bf16(v0[2] * bf_lo(gg.y), v0[3] * bf_hi(gg.y));
            w.z = cvt_pk_bf16(v1[0] * bf_lo(gg.z), v1[1] * bf_hi(gg.z)); w.w = cvt_pk_bf16(v1[2] * bf_lo(gg.w), v1[3] * bf_hi(gg.w));
            *(GAS u32x4*)((char*)(CAT + (size_t)(R0 + 64 * h + row) * DM + g * PGRP) + c8 * 16u) = w; }
    }
    LDS_WAIT(); __syncthreads();
}
template <bool SAMPLE, int NSEGS = 4> __device__ __forceinline__ void conv_block16(Frame& F, int rowA, const f32x2 (&wp)[CW], const float (&wq)[CW], f32x2 bp, float bq, LAS float* Y) {
    const bf16_t* A = WSP(bf16_t, WS_A);
    unsigned ln = (unsigned)F.lane; asm volatile("" : "+v"(ln));
    const unsigned p = 192u * (unsigned)F.wave + 2u * ln, q = 192u * (unsigned)F.wave + 128u + ln;
    constexpr int NT = SAMPLE ? 4 : 16, NSEG = SAMPLE ? NSEGS : 1, NR = NT + CW - 1, GS = 8, NG = (NR + GS - 1) / GS;
#pragma unroll
    for (int seg = 0; seg < NSEG; ++seg) {
        const int r0 = rowA + seg * NT;
        const int pos0 = SAMPLE ? 0 : (r0 & (SEQ - 1));
        const int bs = (r0 - MP) >> 2;
        f32x2 ap[NT]; float aq[NT];
#pragma unroll
        for (int t = 0; t < NT; ++t) { ap[t] = bp; aq[t] = bq; }
        f32x2 vp[3][GS]; float vq[3][GS];
#define CONV_LOAD(gi) do { _Pragma("unroll") for (int i = 0; i < GS; ++i) { const int rr = (gi) * GS + i; const int rel = rr - (CW - 1); \
            if (rr >= NR) { vp[(gi) % 3][i] = (f32x2){0.f, 0.f}; vq[(gi) % 3][i] = 0.f; } \
            else if (SAMPLE && rel < 0) { const float* sp = F.in[6] + ((size_t)bs * CSTATE + (CSTATE + rel)) * DCONV; vp[(gi) % 3][i] = ldg<f32x2>(sp, p * 4u); vq[(gi) % 3][i] = ldg<float>(sp, q * 4u); } \
            else if (SAMPLE || pos0 + rel >= 0) { const bf16_t* ar = A + (size_t)(r0 + rel) * DCONV; const unsigned w2 = ldg<unsigned>(ar, p * 2u); const unsigned w1 = ldg<unsigned short>(ar, q * 2u); \
                vp[(gi) % 3][i] = (f32x2){bf_lo(w2), bf_hi(w2)}; vq[(gi) % 3][i] = bf_lo(w1); } \
            else { vp[(gi) % 3][i] = (f32x2){0.f, 0.f}; vq[(gi) % 3][i] = 0.f; } } } while (0)
        CONV_LOAD(0); if (NG > 1) CONV_LOAD(1);
#pragma unroll
        for (int gi = 0; gi < NG; ++gi) {
            if (gi + 2 < NG) CONV_LOAD(gi + 2);
#pragma unroll
            for (int i = 0; i < GS; ++i) { const int rr = gi * GS + i;
#pragma unroll
                for (int t = 0; t < NT; ++t) { const int j = rr - t; if (rr < NR && j >= 0 && j < CW) { ap[t] += wp[j] * vp[gi % 3][i]; aq[t] += wq[j] * vq[gi % 3][i]; } } }
            __builtin_amdgcn_sched_barrier(0);
        }
#undef CONV_LOAD
#pragma unroll
        for (int t = 0; t < NT; ++t) { *(LAS f32x2*)(Y + (seg * NT + t) * DCONV + p) = ap[t]; Y[(seg * NT + t) * DCONV + q] = aq[t]; }
    }
}
__device__ __forceinline__ void conv_norm16(Frame& F, int rowA, const LAS float* Y, int ntok = 16) {
    bf16_t* CACT = WSP(bf16_t, WS_CACT);
    unsigned ln = (unsigned)F.lane; asm volatile("" : "+v"(ln));
#pragma unroll
    for (int tt = 0; tt < 2; ++tt) { const int t = 2 * F.wave + tt; if (t >= ntok) break;
        f32x4 y[6]; float s = 0.f;
#pragma unroll
        for (int k = 0; k < 6; ++k) { y[k] = *(const LAS f32x4*)(Y + t * DCONV + 256 * k + 4 * ln); s += (y[k][0] + y[k][1]) + (y[k][2] + y[k][3]); }
        const float mean = wave_sum(s) * (1.0f / DCONV); float qq = 0.f;
#pragma unroll
        for (int k = 0; k < 6; ++k) { y[k] = y[k] - mean; qq += (y[k][0] * y[k][0] + y[k][1] * y[k][1]) + (y[k][2] * y[k][2] + y[k][3] * y[k][3]); }
        const float rstd = 1.0f / sqrtf(wave_sum(qq) * (1.0f / DCONV) + EPS);
        f32x4 gk[6], bk[6];
#pragma unroll
        for (int k = 0; k < 6; ++k) { const unsigned c = 256u * k + 4u * ln; gk[k] = ldg<f32x4>(F.in[16], c * 4u); bk[k] = ldg<f32x4>(F.in[17], c * 4u); }
#pragma unroll
        for (int k = 0; k < 6; ++k) { const unsigned c = 256u * k + 4u * ln; const f32x4 g = gk[k], b = bk[k];
            const f32x4 z = y[k] * rstd * g + b;
            u32x2 o; o.x = cvt_pk_bf16(fast_silu(z[0]), fast_silu(z[1])); o.y = cvt_pk_bf16(fast_silu(z[2]), fast_silu(z[3]));
            *(GAS u32x2*)((char*)(CACT + (size_t)(rowA + t) * DCONV) + c * 2u) = o; }
    }
}
constexpr int CV_ROWS = 16 + CW - 1, CV_STAGE = CV_ROWS * DCONV * 2;
__device__ __forceinline__ void conv_stage(Frame& F, LAS unsigned char* S, int rowA, int pos0, size_t src_off = WS_A) {
    const bf16_t* A = WSP(bf16_t, src_off);
    unsigned ln = (unsigned)F.lane; asm volatile("" : "+v"(ln));
#pragma unroll 1
    for (int i = F.wave; i < CV_ROWS * 3; i += NWAVES) { const int row = i / 3, th = i - 3 * row, rel = row - (CW - 1);
        if (pos0 + rel >= 0) __builtin_amdgcn_global_load_lds((const unsigned*)((const char*)(A + (size_t)(rowA + rel) * DCONV) + th * 1024 + ln * 16u), (LAS unsigned*)(S + i * 1024), 16, 0, 0);
        else *(LAS u32x4*)(S + i * 1024 + ln * 16u) = (u32x4){0u, 0u, 0u, 0u}; }
}
__device__ __forceinline__ void p2_conv_unit_prompt(Frame& F, int unit, size_t src_off = WS_A, size_t dst_off = WS_CACT) {
    LAS unsigned char* S = F.lds;
    LAS float* WPT = (LAS float*)(F.lds + CV_STAGE);
    LAS float* MR = WPT + 256;
    bf16_t* CACT = WSP(bf16_t, dst_off);
    unsigned ln = (unsigned)F.lane; asm volatile("" : "+v"(ln));
    const unsigned p = 192u * (unsigned)F.wave + 2u * ln, q = 192u * (unsigned)F.wave + 128u + ln;
    f32x2 wp[CW]; float wq[CW];
#pragma unroll
    for (int j = 0; j < CW; ++j) { wp[j] = ldg<f32x2>(F.in[14] + (size_t)j * DCONV, p * 4u); wq[j] = ldg<float>(F.in[14] + (size_t)j * DCONV, q * 4u); }
    const f32x2 bp = ldg<f32x2>(F.in[15], p * 4u), gp = ldg<f32x2>(F.in[16], p * 4u), hp = ldg<f32x2>(F.in[17], p * 4u);
    const float bq = ldg<float>(F.in[15], q * 4u), gq = ldg<float>(F.in[16], q * 4u), hq = ldg<float>(F.in[17], q * 4u);
    const int pos_u = (unit & 63) * 32;
    conv_stage(F, S, unit * 32, pos_u, src_off);
#pragma unroll 1
    for (int h = 0; h < 2; ++h) { const int rowA = unit * 32 + 16 * h;
        asm volatile("s_waitcnt vmcnt(0) lgkmcnt(0)" ::: "memory"); __syncthreads();
        f32x2 ap[16]; float aq[16];
#pragma unroll
        for (int t = 0; t < 16; ++t) { ap[t] = bp; aq[t] = bq; }
#pragma unroll
        for (int rg = 0; rg < CV_ROWS; rg += 8) {
            unsigned w2[8], w1[8];
#pragma unroll
            for (int i = 0; i < 8; ++i) if (rg + i < CV_ROWS) { w2[i] = *(const LAS unsigned*)(S + (rg + i) * (DCONV * 2) + p * 2u); w1[i] = *(const LAS unsigned short*)(S + (rg + i) * (DCONV * 2) + q * 2u); }
#pragma unroll
            for (int i = 0; i < 8; ++i) if (rg + i < CV_ROWS) { const int rr = rg + i; const f32x2 vp = (f32x2){bf_lo(w2[i]), bf_hi(w2[i])}; const float vq = bf_lo(w1[i]);
#pragma unroll
                for (int t = 0; t < 16; ++t) { const int j = rr - t; if (j >= 0 && j < CW) { ap[t] += wp[j] * vp; aq[t] += wq[j] * vq; } } }
            __builtin_amdgcn_sched_barrier(0); }
        LDS_WAIT(); __syncthreads();
        if (h == 0) conv_stage(F, S, rowA + 16, pos_u + 16, src_off);
        float st[32];
#pragma unroll
        for (int t = 0; t < 16; ++t) { st[t] = (ap[t].x + ap[t].y) + aq[t]; st[16 + t] = (ap[t].x * ap[t].x + ap[t].y * ap[t].y) + aq[t] * aq[t]; }
        float tot = 0.f;
#pragma unroll
        for (int i = 0; i < 32; ++i) { const float w = wave_sum(st[i]); tot = (ln == (unsigned)i) ? w : tot; }
        if (ln < 32u) WPT[F.wave * 32 + (int)ln] = tot;
        LDS_WAIT(); __syncthreads();
        if (F.tid < 16) { float s1 = 0.f, s2 = 0.f;
#pragma unroll
            for (int w = 0; w < 8; ++w) { s1 += WPT[w * 32 + F.tid]; s2 += WPT[w * 32 + 16 + F.tid]; }
            const float mean = s1 * (1.0f / DCONV), var = fmaxf(s2 * (1.0f / DCONV) - mean * mean, 0.f);
            MR[2 * F.tid] = mean; MR[2 * F.tid + 1] = 1.0f / sqrtf(var + EPS); }
        LDS_WAIT(); __syncthreads();
#pragma unroll
        for (int t = 0; t < 16; ++t) { const f32x2 mr = *(const LAS f32x2*)(MR + 2 * t);
            const float z0 = (ap[t].x - mr.x) * mr.y * gp.x + hp.x, z1 = (ap[t].y - mr.x) * mr.y * gp.y + hp.y, z2 = (aq[t] - mr.x) * mr.y * gq + hq;
            char* orow = (char*)(CACT + (size_t)(rowA + t) * DCONV);
            *(GAS unsigned*)(orow + p * 2u) = cvt_pk_bf16(fast_silu(z0), fast_silu(z1));
            *(GAS unsigned short*)(orow + q * 2u) = (unsigned short)(cvt_pk_bf16(fast_silu(z2), 0.f) & 0xffffu); }
    }
    LDS_WAIT(); __syncthreads();
}
__device__ __forceinline__ void p2_conv_unit_sample(Frame& F, int bs) {
    LAS float* Y = (LAS float*)F.lds;
    unsigned p = 192u * (unsigned)F.wave + 2u * (unsigned)F.lane, q = 192u * (unsigned)F.wave + 128u + (unsigned)F.lane;
    asm volatile("" : "+v"(p), "+v"(q));
    f32x2 wp[CW]; float wq[CW];
#pragma unroll
    for (int j = 0; j < CW; ++j) { wp[j] = ldg<f32x2>(F.in[14] + (size_t)j * DCONV, p * 4u); wq[j] = ldg<float>(F.in[14] + (size_t)j * DCONV, q * 4u); }
    const f32x2 bp = ldg<f32x2>(F.in[15], p * 4u); const float bq = ldg<float>(F.in[15], q * 4u);
    const int rowA = MP + bs * DS;
    conv_block16<true, 1>(F, rowA, wp, wq, bp, bq, Y);
    LDS_WAIT(); __syncthreads();
    conv_norm16(F, rowA, Y, DS);
    LDS_WAIT(); __syncthreads();
}
__device__ __forceinline__ void stage_tile256(LAS unsigned char* T, const bf16_t* g, int pitch, int tid_) {
    unsigned tid = (unsigned)tid_; asm volatile("" : "+v"(tid));
    const unsigned r5 = tid >> 5, ch = tid & 31u, voff = r5 * (unsigned)pitch * 2u + ch * 16u, loff = r5 * 512u + ((ch ^ (r5 & 15u)) << 4);
    u32x4 v[16];
#pragma unroll
    for (int i = 0; i < 16; ++i) v[i] = ldg<u32x4>(g + (size_t)(16 * i) * pitch, voff);
#pragma unroll
    for (int i = 0; i < 16; ++i) *(LAS u32x4*)(T + loff + i * 8192) = v[i];
}
__device__ __forceinline__ void p2_attn_prompt_unit(Frame& F, int unit) {
    const int qb = unit & 15, h = (unit >> 4) & 3, b = unit >> 6;
    int ln_ = F.lane; asm volatile("" : "+v"(ln_));
    const int fr = ln_ & 15, g = ln_ >> 4;
    const int row = b * SEQ + qb * 128 + F.wave * 16 + fr;
    const bf16_t* Q = WSP(bf16_t, WS_Q); const bf16_t* KP = WSP(bf16_t, WS_KP); const bf16_t* VPT = WSP(bf16_t, WS_VPT); const bf16_t* SGC = WSP(bf16_t, WS_SGC); bf16_t* CAT = WSP(bf16_t, WS_CAT);
    LAS unsigned char* T = F.lds;
    stage_tile256(T, KP + (size_t)(b * NMEM) * DX + h * HD, DX, F.tid);
    bf16x8 qf[8];
#pragma unroll
    for (int ks = 0; ks < 8; ++ks) qf[ks] = *(const GAS bf16x8*)(Q + (size_t)row * DX + h * HD + 32 * ks + 8 * g);
    LDS_WAIT(); __syncthreads();
    f32x4 s[16];
    const int xt = g ^ fr;
#pragma unroll
    for (int nb = 0; nb < 16; ++nb) { s[nb] = (f32x4){0.f, 0.f, 0.f, 0.f}; bf16x8 kf[8];
#pragma unroll
        for (int ks = 0; ks < 8; ++ks) kf[ks] = *(const LAS bf16x8*)(T + (16 * nb + fr) * 512 + (((4 * ks) ^ xt) << 4));
#pragma unroll
        for (int ks = 0; ks < 8; ++ks) s[nb] = __builtin_amdgcn_mfma_f32_16x16x32_bf16(kf[ks], qf[ks], s[nb], 0, 0, 0); }
    float mx = -3.0e38f;
#pragma unroll
    for (int nb = 0; nb < 16; ++nb) mx = fmaxf(fmaxf(fmaxf(s[nb][0], s[nb][1]), fmaxf(s[nb][2], s[nb][3])), mx);
    mx = fmaxf(mx, __shfl_xor(mx, 16)); mx = fmaxf(mx, __shfl_xor(mx, 32));
    const float sc = 0.0625f * 1.44269504089f; float sum = 0.f;
#pragma unroll
    for (int nb = 0; nb < 16; ++nb)
#pragma unroll
        for (int r = 0; r < 4; ++r) { const float p = __builtin_amdgcn_exp2f((s[nb][r] - mx) * sc); s[nb][r] = p; sum += p; }
    sum += __shfl_xor(sum, 16); sum += __shfl_xor(sum, 32);
    const float inv = 1.0f / sum;
    bf16x8 pf[8];
#pragma unroll
    for (int i = 0; i < 8; ++i) { u32x4 w; w.x = cvt_pk_bf16(s[2 * i][0], s[2 * i][1]); w.y = cvt_pk_bf16(s[2 * i][2], s[2 * i][3]); w.z = cvt_pk_bf16(s[2 * i + 1][0], s[2 * i + 1][1]); w.w = cvt_pk_bf16(s[2 * i + 1][2], s[2 * i + 1][3]);
        pf[i] = __builtin_bit_cast(bf16x8, w); }
    u32x2 gts[16];
#pragma unroll
    for (int eb = 0; eb < 16; ++eb) gts[eb] = *(const GAS u32x2*)(SGC + (size_t)row * DX + h * HD + 16 * eb + 4 * g);
    __syncthreads();
    stage_tile256(T, VPT + (size_t)(h * HD) * DX + b * NMEM, DX, F.tid);
    LDS_WAIT(); __syncthreads();
#pragma unroll
    for (int eb = 0; eb < 16; ++eb) { f32x4 o = (f32x4){0.f, 0.f, 0.f, 0.f};
        u32x2 lo[8], hi[8];
#pragma unroll
        for (int i = 0; i < 8; ++i) { const int e = 16 * eb + fr;
            const LAS unsigned char* rp = T + e * 512 + 8 * (g & 1);
            lo[i] = *(const LAS u32x2*)(rp + (((4 * i + (g >> 1)) ^ fr) << 4)); hi[i] = *(const LAS u32x2*)(rp + (((4 * i + 2 + (g >> 1)) ^ fr) << 4)); }
#pragma unroll
        for (int i = 0; i < 8; ++i) { const u32x4 w = (u32x4){lo[i].x, lo[i].y, hi[i].x, hi[i].y};
            o = __builtin_amdgcn_mfma_f32_16x16x32_bf16(__builtin_bit_cast(bf16x8, w), pf[i], o, 0, 0, 0); }
        const u32x2 gt = gts[eb];
        u32x2 w; w.x = cvt_pk_bf16(o[0] * inv * bf_lo(gt.x), o[1] * inv * bf_hi(gt.x)); w.y = cvt_pk_bf16(o[2] * inv * bf_lo(gt.y), o[3] * inv * bf_hi(gt.y));
        *(GAS u32x2*)(CAT + (size_t)row * DM + 3072 + h * HD + 16 * eb + 4 * g) = w; }
    LDS_WAIT(); __syncthreads();
}
__device__ __forceinline__ void attn_sample_head_unit(Frame& F, int unit) {
    const int b = unit >> 2, head = unit & 3;
    unsigned ln = (unsigned)F.lane; asm volatile("" : "+v"(ln));
    const unsigned hk = ln >> 5, e0 = (ln & 31u) * 8u;
    const bf16_t* Q = WSP(bf16_t, WS_Q); const bf16_t* SGC = WSP(bf16_t, WS_SGC); bf16_t* CAT = WSP(bf16_t, WS_CAT);
    LAS float* SL = (LAS float*)F.lds;
    LAS float* OL = (LAS float*)(F.lds + 4096);
    float q[4][8];
#pragma unroll
    for (int t = 0; t < 4; ++t) { const u32x4 w = ldg<u32x4>(Q + (size_t)(MP + b * DS + t) * DX + head * HD, e0 * 2u);
        q[t][0] = bf_lo(w.x); q[t][1] = bf_hi(w.x); q[t][2] = bf_lo(w.y); q[t][3] = bf_hi(w.y); q[t][4] = bf_lo(w.z); q[t][5] = bf_hi(w.z); q[t][6] = bf_lo(w.w); q[t][7] = bf_hi(w.w); }
    const float* Kc = F.in[3] + (size_t)b * NMEM * DX + head * HD + (size_t)(32 * F.wave) * DX;
    const float* Vc = F.in[4] + (size_t)b * NMEM * DX + head * HD + (size_t)(32 * F.wave) * DX;
    const unsigned koff = hk * (DX * 4u) + e0 * 4u;
#pragma unroll 1
    for (int kb = 0; kb < 2; ++kb) {
        f32x4 ka[8], kc[8];
#pragma unroll
        for (int j = 0; j < 8; ++j) { const float* pp = Kc + (size_t)(16 * kb + 2 * j) * DX; ka[j] = ldg_nt<f32x4>(pp, koff); kc[j] = ldg_nt<f32x4>(pp, koff + 16u); }
#pragma unroll
        for (int j = 0; j < 8; ++j) { float d[4];
#pragma unroll
            for (int t = 0; t < 4; ++t) d[t] = (ka[j].x * q[t][0] + ka[j].y * q[t][1]) + (ka[j].z * q[t][2] + ka[j].w * q[t][3]) + (kc[j].x * q[t][4] + kc[j].y * q[t][5]) + (kc[j].z * q[t][6] + kc[j].w * q[t][7]);
#pragma unroll
            for (int t = 0; t < 4; ++t) {
#pragma unroll
                for (int o = 1; o < 32; o <<= 1) d[t] += __shfl_xor(d[t], o); }
            if ((ln & 31u) == 0u) *(LAS f32x4*)(SL + (32 * F.wave + 16 * kb + 2 * j + (int)hk) * 4) = (f32x4){d[0], d[1], d[2], d[3]}; } }
    LDS_WAIT(); __syncthreads();
    if (F.wave < 4) { const int st = F.wave; float v[4]; float mx = -3.0e38f;
#pragma unroll
        for (int i = 0; i < 4; ++i) { v[i] = SL[(ln + 64u * i) * 4 + st]; mx = fmaxf(mx, v[i]); }
#pragma unroll
        for (int o = 1; o < 64; o <<= 1) mx = fmaxf(mx, __shfl_xor(mx, o));
        float sum = 0.f;
#pragma unroll
        for (int i = 0; i < 4; ++i) { v[i] = __builtin_amdgcn_exp2f((v[i] - mx) * (0.0625f * 1.44269504089f)); sum += v[i]; }
        sum = wave_sum(sum); const float inv = 1.0f / sum;
#pragma unroll
        for (int i = 0; i < 4; ++i) SL[(ln + 64u * i) * 4 + st] = v[i] * inv; }
    LDS_WAIT(); __syncthreads();
    float o[4][8];
#pragma unroll
    for (int t = 0; t < 4; ++t)
#pragma unroll
        for (int e = 0; e < 8; ++e) o[t][e] = 0.f;
#pragma unroll 1
    for (int kb = 0; kb < 2; ++kb) {
        f32x4 va[8], vc[8];
#pragma unroll
        for (int j = 0; j < 8; ++j) { const float* pp = Vc + (size_t)(16 * kb + 2 * j) * DX; va[j] = ldg_nt<f32x4>(pp, koff); vc[j] = ldg_nt<f32x4>(pp, koff + 16u); }
#pragma unroll
        for (int j = 0; j < 8; ++j) { const f32x4 pr = *(const LAS f32x4*)(SL + (32 * F.wave + 16 * kb + 2 * j + (int)hk) * 4);
#pragma unroll
            for (int t = 0; t < 4; ++t) { o[t][0] += pr[t] * va[j].x; o[t][1] += pr[t] * va[j].y; o[t][2] += pr[t] * va[j].z; o[t][3] += pr[t] * va[j].w; o[t][4] += pr[t] * vc[j].x; o[t][5] += pr[t] * vc[j].y; o[t][6] += pr[t] * vc[j].z; o[t][7] += pr[t] * vc[j].w; } } }
#pragma unroll
    for (int t = 0; t < 4; ++t)
#pragma unroll
        for (int e = 0; e < 8; ++e) o[t][e] += __shfl_xor(o[t][e], 32);
    if (hk == 0u) {
#pragma unroll
        for (int t = 0; t < 4; ++t) { LAS float* pp = OL + (F.wave * 4 + t) * 256 + e0; *(LAS f32x4*)pp = (f32x4){o[t][0], o[t][1], o[t][2], o[t][3]}; *(LAS f32x4*)(pp + 4) = (f32x4){o[t][4], o[t][5], o[t][6], o[t][7]}; } }
    LDS_WAIT(); __syncthreads();
    if (F.tid < 256) { const int t = F.tid >> 6, e = (F.tid & 63) * 4;
        f32x4 a = (f32x4){0.f, 0.f, 0.f, 0.f};
#pragma unroll
        for (int w = 0; w < 8; ++w) a += *(const LAS f32x4*)(OL + (w * 4 + t) * 256 + e);
        const size_t row = (size_t)(MP + b * DS + t); const int col = head * HD + e;
        const u32x2 gt = *(const GAS u32x2*)(SGC + row * DX + col);
        u32x2 w; w.x = cvt_pk_bf16(a[0] * bf_lo(gt.x), a[1] * bf_hi(gt.x)); w.y = cvt_pk_bf16(a[2] * bf_lo(gt.y), a[3] * bf_hi(gt.y));
        *(GAS u32x2*)(CAT + row * DM + 3072 + col) = w; }
    LDS_WAIT(); __syncthreads();
}

constexpr int NAS_UNITS = DB * NH, NAS_FREE_FROM = G1_ALL - 5 * 256;
constexpr int P2_NAS = 256, P2_NAP = 256, P2_NCV = 256 + MS / 16, P2_NPL = MT / 32;
__device__ __forceinline__ void p2_mixers(LAS unsigned char* lds) {
    if ((int)gridDim.x != 256) { Frame F = make_frame(lds); for (int u = F.vcu; u < NAS_UNITS; u += F.G) attn_sample_head_unit(F, u); }
    { Frame F = make_frame(lds); for (int u = F.vcu; u < P2_NAP; u += F.G) p2_attn_prompt_unit(F, u); }
    { Frame F = make_frame(lds); for (int u = F.vcu; u < 256; u += F.G) p2_conv_unit_prompt(F, u); }
    { Frame F = make_frame(lds); for (int bs = (F.vcu + F.G - 64) % F.G; bs < DB; bs += F.G) p2_conv_unit_sample(F, bs); }
    { Frame F = make_frame(lds); const bool fused = (int)gridDim.x == 256;
      for (int u = F.vcu; u < 256; u += F.G) p2_poolmix_unit(F, u); }
    { Frame F = make_frame(lds);
      for (int sidx = ((F.vcu + F.G - 192) % F.G) * NWAVES + F.wave; sidx < 16 * 24; sidx += F.G * NWAVES) p2_pool_sample_task(F, sidx); }
    { Frame F = make_frame(lds); p2_states(F); if ((int)gridDim.x != 256) states_copy_rows(F, F.vcu * NWAVES + F.wave, F.G * NWAVES); }
}

struct Sched3pw { int G, c; const char *CACT, *WPW;
    __device__ __forceinline__ bool next(int i, Unit& u) const { const int L = i * G + c; if (L >= G1_NM * 6) return false;
        int pm, pn; pg8::tile_order(L, G1_NM, 6, pm, pn); u.pm = pm; u.pn = pn; u.kind = 0; u.nt = DCONV / 64; u.A = CACT + (size_t)pm * 256 * DCONV * 2; u.B = WPW + (size_t)pn * 256 * DCONV * 2; return true; } };
struct Sched3pl { int G, c; const char *POOLED, *WPOOL;
    __device__ __forceinline__ bool next(int i, Unit& u) const { const int L = i * G + c; if (L >= 2 * 8) return false;
        const int pm = MP / 256 + (L >> 3), pn = L & 7; u.pm = pm; u.pn = pn; u.kind = 1; u.nt = PGRP / 64; const int g = pn >> 1;
        u.A = POOLED + (size_t)pm * 256 * DPOOL * 2 + (size_t)g * PGRP * 2; u.B = WPOOL + (size_t)pn * 256 * PGRP * 2; return true; } };
template <int KIND> struct Epi3 {
    const bf16_t *SGA, *SGB; const float* pscale; bf16_t* CAT;
    __device__ __forceinline__ void operator()(const f32x4 (&acc)[2][2][4][2], const Unit& u, int wr, int wc, int fr, int fq) const {
        const int row0 = u.pm * 256 + wr * 64 + fr, cl = wc * 32 + 8 * fq;
        if constexpr (KIND == 0) {
            const int col0 = u.pn * 256 + cl;
            u32x4 gts[2][4][2];
#pragma unroll
            for (int ai = 0; ai < 2; ++ai)
#pragma unroll
                for (int m = 0; m < 4; ++m)
#pragma unroll
                    for (int bj = 0; bj < 2; ++bj) gts[ai][m][bj] = *(const u32x4*)(SGB + (size_t)(row0 + ai * 128 + m * 16) * DCONV + col0 + bj * 128);
#pragma unroll
            for (int ai = 0; ai < 2; ++ai)
#pragma unroll
                for (int m = 0; m < 4; ++m)
#pragma unroll
                    for (int bj = 0; bj < 2; ++bj) { const size_t r = (size_t)(row0 + ai * 128 + m * 16); const int c = col0 + bj * 128;
                        const u32x4 gt = gts[ai][m][bj]; const f32x4 v0 = acc[ai][bj][m][0], v1 = acc[ai][bj][m][1];
                        u32x4 w; w.x = cvt_pk_bf16(v0[0] * bf_lo(gt.x), v0[1] * bf_hi(gt.x)); w.y = cvt_pk_bf16(v0[2] * bf_lo(gt.y), v0[3] * bf_hi(gt.y));
                        w.z = cvt_pk_bf16(v1[0] * bf_lo(gt.z), v1[1] * bf_hi(gt.z)); w.w = cvt_pk_bf16(v1[2] * bf_lo(gt.w), v1[3] * bf_hi(gt.w));
                        *(u32x4*)(CAT + r * DM + DPOOL + c) = w; }
        } else {
            const int g = u.pn >> 1, half = u.pn & 1;
#pragma unroll
            for (int bj = 0; bj < 2; ++bj) { const int cg = half * 256 + bj * 128 + cl;
                if (!(half == 1 && bj == 1)) { const int c = g * PGRP + cg;
                    const f32x4 s0 = *(const f32x4*)(pscale + c), s1 = *(const f32x4*)(pscale + c + 4);
                    u32x4 gts[2][4];
#pragma unroll
                    for (int ai = 0; ai < 2; ++ai)
#pragma unroll
                        for (int m = 0; m < 4; ++m) gts[ai][m] = *(const u32x4*)(SGA + (size_t)(row0 + ai * 128 + m * 16) * DPOOL + c);
#pragma unroll
                    for (int ai = 0; ai < 2; ++ai)
#pragma unroll
                        for (int m = 0; m < 4; ++m) { const size_t r = (size_t)(row0 + ai * 128 + m * 16);
                            const u32x4 gt = gts[ai][m]; const f32x4 v0 = acc[ai][bj][m][0] * s0, v1 = acc[ai][bj][m][1] * s1;
                            u32x4 w; w.x = cvt_pk_bf16(v0[0] * bf_lo(gt.x), v0[1] * bf_hi(gt.x)); w.y = cvt_pk_bf16(v0[2] * bf_lo(gt.y), v0[3] * bf_hi(gt.y));
                            w.z = cvt_pk_bf16(v1[0] * bf_lo(gt.z), v1[1] * bf_hi(gt.z)); w.w = cvt_pk_bf16(v1[2] * bf_lo(gt.w), v1[3] * bf_hi(gt.w));
                            *(u32x4*)(CAT + r * DM + c) = w; } } }
        }
    }
};

struct Sched4 { int G, c; const char *CAT, *WOUT;
    __device__ __forceinline__ bool next(int i, Unit& u) const {
        constexpr int NPT = (MP / 256) * 16;
        const int L = i * G + c;
        if (L < NPT) { int pm, pn; pg8::tile_order(L, MP / 256, 16, pm, pn); u.pm = pm; u.pn = pn; u.kind = 0; u.nt = DM / 64; u.A = CAT + (size_t)pm * TSTEP4K; u.B = WOUT + (size_t)pn * TSTEP4K; return true; }
        const int q = L - NPT; if (q >= 256) return false;
        const int r = q >> 3, p = q & 7, pm = MP / 256 + (r >> 4), pn = r & 15;
        u.pm = pm; u.pn = pn; u.kind = 1 + p; u.nt = 8; u.A = CAT + (size_t)pm * TSTEP4K + (size_t)p * 1024; u.B = WOUT + (size_t)pn * TSTEP4K + (size_t)p * 1024; return true;
    }
};
__device__ __forceinline__ unsigned pk_f16(float a, float b) { return (unsigned)__builtin_bit_cast(unsigned short, (_Float16)a) | ((unsigned)__builtin_bit_cast(unsigned short, (_Float16)b) << 16); }
__device__ __forceinline__ float h_lo(unsigned w) { return (float)__builtin_bit_cast(_Float16, (unsigned short)(w & 0xffffu)); }
__device__ __forceinline__ float h_hi(unsigned w) { return (float)__builtin_bit_cast(_Float16, (unsigned short)(w >> 16)); }
struct Epi4 {
    unsigned short* y; unsigned short* part;
    __device__ __forceinline__ void operator()(const f32x4 (&acc)[2][2][4][2], const Unit& u, int wr, int wc, int fr, int fq) const {
        const int row0 = u.pm * 256 + wr * 64 + fr, col0 = u.pn * 256 + wc * 32 + 8 * fq;
        if (u.kind == 0) {
            unsigned short* yb = y + (size_t)row0 * DM + col0;
#pragma unroll
            for (int ai = 0; ai < 2; ++ai)
#pragma unroll
                for (int m = 0; m < 4; ++m) { unsigned short* yp = yb + (size_t)(ai * 128 + m * 16) * DM;
                    const f32x4 y0 = acc[ai][0][m][0], y1 = acc[ai][0][m][1], y2 = acc[ai][1][m][0], y3 = acc[ai][1][m][1];
                    *(u32x4*)yp = (u32x4){pk_f16(y0[0], y0[1]), pk_f16(y0[2], y0[3]), pk_f16(y1[0], y1[1]), pk_f16(y1[2], y1[3])}; *(u32x4*)(yp + 128) = (u32x4){pk_f16(y2[0], y2[1]), pk_f16(y2[2], y2[3]), pk_f16(y3[0], y3[1]), pk_f16(y3[2], y3[3])}; }
        } else {
            unsigned short* pb = part + ((size_t)(u.kind - 1) * MS + (size_t)(row0 - MP)) * DM + col0;
#pragma unroll
            for (int ai = 0; ai < 2; ++ai)
#pragma unroll
                for (int m = 0; m < 4; ++m) { unsigned short* pp = pb + (size_t)(ai * 128 + m * 16) * DM;
                    const f32x4 y0 = acc[ai][0][m][0], y1 = acc[ai][0][m][1], y2 = acc[ai][1][m][0], y3 = acc[ai][1][m][1];
                    *(u32x4*)pp = (u32x4){pk_f16(y0[0], y0[1]), pk_f16(y0[2], y0[3]), pk_f16(y1[0], y1[1]), pk_f16(y1[2], y1[3])}; *(u32x4*)(pp + 128) = (u32x4){pk_f16(y2[0], y2[1]), pk_f16(y2[2], y2[3]), pk_f16(y3[0], y3[1]), pk_f16(y3[2], y3[3])}; }
        }
    }
};

template <bool SAMPLE> __device__ __forceinline__ void p5_row(Frame& F, int m, float* dst) {
    f32x4 v[16];
    const GAS f32x4* x8 = (const GAS f32x4*)((SAMPLE ? F.in[2] + (size_t)(m - MP) * DM : F.in[0] + (size_t)m * DM)) + 2 * F.lane;
    if (!SAMPLE) {
        const GAS u32x4* yr = (const GAS u32x4*)(F.ws + WS_YH + (size_t)m * DM * 2) + F.lane;
        u32x4 w[8];
#pragma unroll
        for (int j = 0; j < 8; ++j) { w[j] = yr[64 * j]; v[2 * j] = x8[128 * j]; v[2 * j + 1] = x8[128 * j + 1]; }
#pragma unroll
        for (int j = 0; j < 8; ++j) { v[2 * j] += (f32x4){h_lo(w[j].x), h_hi(w[j].x), h_lo(w[j].y), h_hi(w[j].y)}; v[2 * j + 1] += (f32x4){h_lo(w[j].z), h_hi(w[j].z), h_lo(w[j].w), h_hi(w[j].w)}; }
    } else {
#pragma unroll
        for (int j = 0; j < 8; ++j) { v[2 * j] = x8[128 * j]; v[2 * j + 1] = x8[128 * j + 1]; }
#pragma unroll 2
        for (int p = 0; p < 8; ++p) { const GAS u32x4* pr = (const GAS u32x4*)(F.ws + WS_SLAB + ((size_t)p * MS + (m - MP)) * DM * 2) + F.lane;
            u32x4 w[8];
#pragma unroll
            for (int j = 0; j < 8; ++j) w[j] = pr[64 * j];
#pragma unroll
            for (int j = 0; j < 8; ++j) { v[2 * j] += (f32x4){h_lo(w[j].x), h_hi(w[j].x), h_lo(w[j].y), h_hi(w[j].y)}; v[2 * j + 1] += (f32x4){h_lo(w[j].z), h_hi(w[j].z), h_lo(w[j].w), h_hi(w[j].w)}; } }
    }
    float s = 0.f;
#pragma unroll
    for (int j = 0; j < 16; ++j) s += (v[j].x * v[j].x + v[j].y * v[j].y) + (v[j].z * v[j].z + v[j].w * v[j].w);
    const float rstd = 1.0f / sqrtf(wave_sum(s) * (1.0f / DM) + EPS);
    const GAS f32x4* g8 = (const GAS f32x4*)F.in[20] + 2 * F.lane; GAS f32x4* y8 = (GAS f32x4*)(dst + (size_t)m * DM) + 2 * F.lane;
    f32x4 gv[16];
#pragma unroll
    for (int j = 0; j < 8; ++j) { gv[2 * j] = g8[128 * j]; gv[2 * j + 1] = g8[128 * j + 1]; }
#pragma unroll
    for (int j = 0; j < 8; ++j) { y8[128 * j] = v[2 * j] * rstd * gv[2 * j]; y8[128 * j + 1] = v[2 * j + 1] * rstd * gv[2 * j + 1]; }
}
__device__ __forceinline__ void p5_final_norm(Frame& F, float* dst) {
    const int gw = F.vcu * NWAVES + F.wave, NGW = F.G * NWAVES;
    for (int r = F.wave * F.G + F.vcu; r < MS; r += NGW) p5_row<true>(F, MP + r, dst);
    for (int m = gw; m < MP; m += NGW) p5_row<false>(F, m, dst);
}

__global__ void __launch_bounds__(NTHR, 2) hybrid_fwd(Args args) {
    extern __shared__ __attribute__((aligned(16))) unsigned char lds_raw[];
    LAS unsigned char* lds = (LAS unsigned char*)lds_raw;
    volatile LAS unsigned* MISC = (volatile LAS unsigned*)(lds + LDSCTL_OFF);
    if (threadIdx.x < 64) MISC[threadIdx.x] = 0u;
    __syncthreads();
    XcdBarrier bar = xcd_barrier_post((unsigned*)(args.ws + WS_CTL) + CW_BAR, MISC + 8);

    { Frame F = make_frame(lds); p0_prologue(F, (int)gridDim.x != 256); }
    xcd_barrier(bar);
    { Frame F = make_frame(lds);
      Sched1 S{F.G, (int)blockIdx.x, (const char*)(F.ws + WS_H), (const char*)(F.ws + WS_HM), (const char*)(F.ws + WS_WIN), (const char*)(F.ws + WS_WKV)};
      Epi1 E{WSP(bf16_t, WS_U), WSP(bf16_t, WS_SGA), WSP(bf16_t, WS_A), WSP(bf16_t, WS_SGB), WSP(bf16_t, WS_Q), WSP(bf16_t, WS_SGC), WSP(bf16_t, WS_KP), WSP(bf16_t, WS_VPT), F.out + O_MK, F.out + O_MV, (unsigned*)(F.ws + WS_CTL) + CW_QREADY};
      pg8::gemm_phase<Epi1, Sched1, true, true>(F.lds, DM, DM, S, E); }
    if ((int)blockIdx.x >= NAS_FREE_FROM && (int)gridDim.x == 256) {
        Frame F = make_frame(lds);
        if (F.tid < 64) { unsigned* fl = (unsigned*)(F.ws + WS_CTL) + CW_QREADY; unsigned sp = 0;
            while (__hip_atomic_load(fl, __ATOMIC_RELAXED, __HIP_MEMORY_SCOPE_AGENT) < (unsigned)G1_SPECIAL) { __builtin_amdgcn_s_sleep(4); if (++sp > (1u << 22)) break; }
            __builtin_amdgcn_fence(__ATOMIC_ACQUIRE, "agent"); }
        asm volatile("s_waitcnt vmcnt(0)" ::: "memory"); __syncthreads();
        for (int u = (int)blockIdx.x - NAS_FREE_FROM; u < NAS_UNITS; u += 256 - NAS_FREE_FROM) attn_sample_head_unit(F, u);
    }
    {
        constexpr int NFREE = 256 - NAS_FREE_FROM, N3 = NAS_UNITS - 2 * NFREE, NLATE = NFREE - N3;
        const int idx = (int)blockIdx.x - NAS_FREE_FROM - N3;
        if (idx >= 0 && (int)gridDim.x == 256) { Frame F = make_frame(lds);
            p0_items(F, NITEMS_EARLY, NITEMS, idx * NWAVES + F.wave, NLATE * NWAVES);
            p0_pool_pad(F, idx * NTHR + F.tid, NLATE * NTHR); p0_pool_frag(F, idx * NTHR + F.tid, NLATE * NTHR); }
    }
    if ((int)blockIdx.x >= NAS_FREE_FROM && (int)gridDim.x == 256) {
        Frame F = make_frame(lds); states_copy_rows(F, ((int)blockIdx.x - NAS_FREE_FROM) * NWAVES + F.wave, (256 - NAS_FREE_FROM) * NWAVES); }
    xcd_barrier(bar);
    p2_mixers(lds);
    xcd_barrier(bar);
    { Frame F = make_frame(lds);
      Epi3<0> E{WSP(bf16_t, WS_SGA), WSP(bf16_t, WS_SGB), F.in[13], WSP(bf16_t, WS_CAT)};
      Sched3pw Sw{F.G, (int)blockIdx.x, (const char*)(F.ws + WS_CACT), (const char*)(F.ws + WS_WPW)};
      pg8::gemm_phase<Epi3<0>, Sched3pw, true, true>(F.lds, DCONV, DCONV, Sw, E); }
    { Frame F = make_frame(lds);
      Epi3<1> E{WSP(bf16_t, WS_SGA), WSP(bf16_t, WS_SGB), F.in[13], WSP(bf16_t, WS_CAT)};
      Sched3pl Sp{F.G, (int)((blockIdx.x + 52) % F.G), (const char*)(F.ws + WS_POOLED), (const char*)(F.ws + WS_WPOOL)};
      pg8::gemm_phase<Epi3<1>, Sched3pl, true, true>(F.lds, DPOOL, PGRP, Sp, E); }
    xcd_barrier(bar);
    { Frame F = make_frame(lds);
      Sched4 S{F.G, (int)blockIdx.x, (const char*)(F.ws + WS_CAT), (const char*)(F.ws + WS_WOUT)};
      Epi4 E{(unsigned short*)(F.ws + WS_YH), (unsigned short*)(F.ws + WS_SLAB)};
      pg8::gemm_phase<Epi4, Sched4, true, true>(F.lds, DM, DM, S, E); }
    xcd_barrier(bar);
    { Frame F = make_frame(lds); p5_final_norm(F, F.out + O_Y); }
}

extern "C" void kernel_launch(void* const* d_in, const int* in_sizes, int n_in, void* d_out, int out_size, void* d_ws, size_t ws_size, hipStream_t stream) {
    static int grid = 0;
    if (grid == 0) {
        if (n_in != 21 || (size_t)out_size != O_END || ws_size < WS_END) { fprintf(stderr, "kernel_launch: unexpected shapes: n_in %d out %d ws %zu (need %zu)\n", n_in, out_size, ws_size, (size_t)WS_END); grid = -1; return; }
        int dev = 0, cus = 0, per_cu = 0;
        if (hipGetDevice(&dev) != hipSuccess || hipDeviceGetAttribute(&cus, hipDeviceAttributeMultiprocessorCount, dev) != hipSuccess) { grid = -1; return; }
        if (hipFuncSetAttribute((const void*)hybrid_fwd, hipFuncAttributeMaxDynamicSharedMemorySize, LDS_BYTES) != hipSuccess) { fprintf(stderr, "kernel_launch: hipFuncSetAttribute failed\n"); grid = -1; return; }
        if (hipOccupancyMaxActiveBlocksPerMultiprocessor(&per_cu, (const void*)hybrid_fwd, NTHR, LDS_BYTES) != hipSuccess || per_cu < 1) { fprintf(stderr, "kernel_launch: occupancy query reports %d blocks per CU\n", per_cu); }
        (void)hipGetLastError();
        grid = cus;
    }
    if (grid < 0) return;
    unsigned char* wsb = (unsigned char*)d_ws + ((ws_size - WS_END) & ~(size_t)(2 * MiB - 1));
    if (hipMemsetAsync((char*)wsb + WS_CTL, 0, CTL_ZERO_BYTES, stream) != hipSuccess) { fprintf(stderr, "kernel_launch: memset failed\n"); return; }
    Args a{};
    for (int i = 0; i < 21; ++i) a.in[i] = (const float*)d_in[i];
    a.out = (float*)d_out; a.ws = wsb;
    hipLaunchKernelGGL(hybrid_fwd, dim3(grid), dim3(NTHR), LDS_BYTES, stream, a);
}
```

```cpp
#include <hip/hip_runtime.h>
#include <cstdio>
#include <cstdint>

#define LAS __attribute__((address_space(3)))
#define GAS __attribute__((address_space(1)))
typedef unsigned short bf16_t;
typedef short bf16x8 __attribute__((ext_vector_type(8)));
typedef float f32x4 __attribute__((ext_vector_type(4)));
typedef float f32x2 __attribute__((ext_vector_type(2)));
typedef unsigned u32x4 __attribute__((ext_vector_type(4)));
typedef unsigned u32x2 __attribute__((ext_vector_type(2)));
typedef GAS unsigned gu32;

constexpr int DM = 4096, NB = 4, SEQ = 2048, DB = 128, DS = 4, NMEM = 256;
constexpr int DPOOL = 1536, DCONV = 1536, DX = 1024, NH = 4, HD = 256, PGRP = 384, DIN = 9728;
constexpr int MP = NB * SEQ, MS = DB * DS, MT = MP + MS, MM = NB * NMEM;
constexpr int PSTATE = 15, CSTATE = 30, CW = 31;
constexpr float EPS = 1e-6f;

constexpr size_t O_Y = 0;
constexpr size_t O_MK = (size_t)MT * DM;
constexpr size_t O_MV = O_MK + (size_t)MM * DX;
constexpr size_t O_PSP = O_MV + (size_t)MM * DX;
constexpr size_t O_CSP = O_PSP + (size_t)NB * PSTATE * DPOOL;
constexpr size_t O_PSS = O_CSP + (size_t)NB * CSTATE * DCONV;
constexpr size_t O_CSS = O_PSS + (size_t)DB * PSTATE * DPOOL;
constexpr size_t O_END = O_CSS + (size_t)DB * CSTATE * DCONV;

constexpr size_t MiB = 1u << 20;
constexpr size_t WS_CTL = 0, CTL_BYTES = 1 * MiB;
constexpr size_t WS_WOUT = 1 * MiB;
constexpr size_t WS_WPW = WS_WOUT + 32 * MiB;
constexpr size_t WS_WPOOL = WS_WPW + 5 * MiB;
constexpr size_t WS_WPOOLF = WS_WPOOL + 2 * MiB;
constexpr size_t WS_U = WS_WPOOLF + 2 * MiB;
constexpr size_t WS_SGA = WS_U + 26 * MiB;
constexpr size_t WS_A = WS_SGA + 26 * MiB;
constexpr size_t WS_SGB = WS_A + 26 * MiB;
constexpr size_t WS_Q = WS_SGB + 26 * MiB;
constexpr size_t WS_SGC = WS_Q + 17 * MiB;
constexpr size_t WS_KP = WS_SGC + 17 * MiB;
constexpr size_t WS_VPT = WS_KP + 2 * MiB;
constexpr size_t WS_POOLED = WS_VPT + 2 * MiB;
constexpr size_t WS_CACT = WS_POOLED + 26 * MiB;
constexpr size_t WS_CAT = WS_CACT + 26 * MiB;
constexpr size_t WS_SLAB = WS_CAT + 68 * MiB;
constexpr size_t WS_ROWSS = WS_SLAB + 64 * MiB;
constexpr size_t WS_YH = WS_ROWSS + 2 * MiB;
constexpr size_t WS_HM = WS_YH + 64 * MiB;
constexpr size_t WS_H = WS_HM + 8 * MiB;
constexpr size_t WS_WKV = WS_H + 68 * MiB;
constexpr size_t WS_WIN = WS_WKV + 16 * MiB;
constexpr size_t WS_END = WS_WIN + 76 * MiB;
constexpr int CW_BAR = 4096;
constexpr int CW_QREADY = 8192;
constexpr size_t CTL_ZERO_BYTES = 40 * 1024;
static_assert((CW_QREADY + 64) * 4 <= (int)CTL_ZERO_BYTES && (CW_BAR + 3456 + 64) * 4 <= (int)CTL_ZERO_BYTES, "ctl");

constexpr int RING_BYTES = 131072;
constexpr int LDS_BYTES = 163840;
constexpr int LDSCTL_OFF = LDS_BYTES - 1024;
constexpr int NWAVES = 8, NTHR = 512;

#define RLX_AGENT __ATOMIC_RELAXED, __HIP_MEMORY_SCOPE_AGENT
#define LDS_WAIT() asm volatile("s_waitcnt lgkmcnt(0)" ::: "memory")
#define VM_WAIT() asm volatile("s_waitcnt vmcnt(0)" ::: "memory")

__device__ __forceinline__ unsigned cvt_pk_bf16(float lo, float hi) { unsigned r; asm volatile("v_cvt_pk_bf16_f32 %0, %1, %2" : "=v"(r) : "v"(lo), "v"(hi)); return r; }
__device__ __forceinline__ float bf_lo(unsigned w) { return __uint_as_float(w << 16); }
__device__ __forceinline__ float bf_hi(unsigned w) { return __uint_as_float(w & 0xffff0000u); }
__device__ __forceinline__ float fast_sigmoid(float x) { return __builtin_amdgcn_rcpf(1.0f + __builtin_amdgcn_exp2f(-1.44269504089f * x)); }
__device__ __forceinline__ float fast_silu(float x) { return x * fast_sigmoid(x); }
__device__ __forceinline__ float wave_reduce32(float (&v)[32], int lane) {
#pragma unroll
    for (int s = 0; s < 5; ++s) { const int half = 16 >> s; const bool up = (lane >> s) & 1;
#pragma unroll
        for (int i = 0; i < half; ++i) { const float keep = up ? v[i + half] : v[i], send = up ? v[i] : v[i + half]; v[i] = keep + __shfl_xor(send, 1 << s); } }
    return v[0] + __shfl_xor(v[0], 32);
}
template <class T> __device__ __forceinline__ T ldg_nt(const void* ubase, unsigned boff) { return __builtin_nontemporal_load((const GAS T*)((const char*)ubase + boff)); }
template <class T> __device__ __forceinline__ T ldg(const void* ubase, unsigned boff) { return *(const GAS T*)((const char*)ubase + boff); }
__device__ __forceinline__ float wave_sum(float v) {
#pragma unroll
    for (int o = 1; o < 64; o <<= 1) v += __shfl_xor(v, o);
    return v;
}

__device__ __forceinline__ int fresh_tid() { int t = threadIdx.x; asm volatile("" : "+v"(t)); return t; }

#define XB_TMO      128
#define XB_XCNT(j)  (256  + 64 * (j))
#define XB_XSUB(j)  (1280 + 64 * (j))
#define XB_XGEN(j)  (2304 + 64 * (j))
#define XB_TOP      3328
#define XB_TOPGEN   3392
#define XCD_BAR_WORDS 3456
#define XB_SPIN_CAP (1u << 18)
__device__ __forceinline__ unsigned xb_ld(unsigned* p)              { return __hip_atomic_load(p, __ATOMIC_RELAXED, __HIP_MEMORY_SCOPE_AGENT); }
__device__ __forceinline__ unsigned xb_add(unsigned* p, unsigned v) { return __hip_atomic_fetch_add(p, v, __ATOMIC_RELAXED, __HIP_MEMORY_SCOPE_AGENT); }
__device__ __forceinline__ unsigned xb_xcc_id() { return (unsigned)__builtin_amdgcn_s_getreg((3 << 11) | 20) & 0xFu; }
#define XB_SPIN(cond, bar) do { unsigned _sp = 0; while (cond) { __builtin_amdgcn_s_sleep(1); \
    if ((++_sp & 255u) == 0u) { if (xb_ld(&(bar)[XB_TMO])) break; if (_sp > XB_SPIN_CAP) { atomicAdd(&(bar)[XB_TMO], 1u); break; } } } } while (0)
struct XcdBarrier { unsigned* bar; unsigned x; volatile LAS unsigned* st; };
__device__ __forceinline__ XcdBarrier xcd_barrier_post(unsigned* bar, volatile LAS unsigned* st) {
    XcdBarrier b; b.bar = bar; b.x = xb_xcc_id(); b.st = st;
    if (threadIdx.x == 0) (void)xb_add(&bar[XB_XCNT(b.x)], 1u);
    return b;
}
__device__ __forceinline__ void xcd_barrier_complete(unsigned* bar, unsigned x, unsigned& nloc, unsigned& nx) {
    const unsigned G = gridDim.x * gridDim.y * gridDim.z;
    unsigned sum, cnt, mine, sp = 0u;
    for (;;) {
        sum = 0u; cnt = 0u; mine = 0u;
#pragma unroll
        for (unsigned j = 0; j < 16; ++j) { const unsigned c = xb_ld(&bar[XB_XCNT(j)]); sum += c; cnt += (c > 0u) ? 1u : 0u; mine = (j == x) ? c : mine; }
        if (sum == G) break;
        __builtin_amdgcn_s_sleep(1);
        if ((++sp & 255u) == 0u) { if (xb_ld(&bar[XB_TMO])) break; if (sp > XB_SPIN_CAP) { atomicAdd(&bar[XB_TMO], 1u); break; } }
    }
    nloc = mine > 0u ? mine : 1u; nx = cnt > 0u ? cnt : 1u;
}
__device__ __forceinline__ void xcd_barrier(const XcdBarrier& b) {
    asm volatile("s_waitcnt vmcnt(0)" ::: "memory");
    __syncthreads();
    if (threadIdx.x == 0) {
        unsigned* bar = b.bar;
        __builtin_amdgcn_s_waitcnt(0);
        unsigned nloc = b.st[0], nx = b.st[1];
        if (nloc == 0u) { xcd_barrier_complete(bar, b.x, nloc, nx); b.st[0] = nloc; b.st[1] = nx; }
        const unsigned old = xb_add(&bar[XB_XSUB(b.x)], 1u);
        const unsigned gen = old / nloc;
        if (old + 1u == (gen + 1u) * nloc) {
            __builtin_amdgcn_fence(__ATOMIC_RELEASE, "agent");
            asm volatile("s_waitcnt vmcnt(0)" ::: "memory");
            const unsigned og = xb_add(&bar[XB_TOP], 1u);
            const unsigned tg = og / nx;
            if (og + 1u == (tg + 1u) * nx) xb_add(&bar[XB_TOPGEN], 1u);
            else XB_SPIN(xb_ld(&bar[XB_TOPGEN]) == tg, bar);
            __builtin_amdgcn_fence(__ATOMIC_ACQUIRE, "agent");
            xb_add(&bar[XB_XGEN(b.x)], 1u);
            asm volatile("s_waitcnt vmcnt(0)" ::: "memory");
        } else {
            XB_SPIN(xb_ld(&bar[XB_XGEN(b.x)]) == gen, bar);
            __builtin_amdgcn_fence(__ATOMIC_ACQUIRE, "agent");
            asm volatile("s_waitcnt vmcnt(0)" ::: "memory");
        }
    }
    __syncthreads();
}

namespace pg8 {
constexpr int BM = 256, BK = 64, HALF = 128, HTB = HALF * BK * 2, STAGE_BYTES = 8 * HTB, NXCD = 8, WGM = 8;
__host__ __device__ __forceinline__ int lds_byte(int r, int c) { const int st = (r >> 4) * 2 + (c >> 5), rr = r & 15, cc = c & 31, ob = rr * 64 + cc * 2; return st * 1024 + (ob ^ (((ob >> 9) & 1) << 5)); }
__host__ __device__ __forceinline__ void stage_rc(int b, int& R, int& C) { const int st = b / 1024, sb = b % 1024, swz = sb ^ (((sb >> 9) & 1) << 5); R = (st >> 1) * 16 + swz / 64; C = (st & 1) * 32 + (swz % 64) / 2; }
__host__ __device__ __forceinline__ int perm32(int rho) { const int n = rho >> 4, i = rho & 15; return 8 * (i >> 2) + 4 * n + (i & 3); }

struct Unit { const char* A; const char* B; int pm, pn, kind, nt; };

__device__ __forceinline__ void tile_order(int L, int nM, int nN, int& pm, int& pn) {
    const int nwg = nM * nN; int wgid = L;
    { const int q = nwg / NXCD, r = nwg % NXCD, xcd = wgid % NXCD, off = wgid / NXCD; wgid = (xcd < r ? xcd * (q + 1) : r * (q + 1) + (xcd - r) * q) + off; }
    const int nig = WGM * nN, gid = wgid / nig, fm = gid * WGM, gsz = (nM - fm) < WGM ? (nM - fm) : WGM;
    pm = fm + ((wgid % nig) % gsz); pn = (wgid % nig) / gsz;
}

template <class Epi, class Sched, bool ALIGN_EPI, bool SP2>
__device__ __forceinline__ void gemm_phase(LAS unsigned char* lds, const int pitchA, const int pitchB, const Sched& S, const Epi& E) {
    const int tid = fresh_tid(), wid = __builtin_amdgcn_readfirstlane(tid >> 6), lane = tid & 63, wr = wid >> 2, wc = wid & 3, fr = lane & 15, fq = lane >> 4;
    unsigned voffA[2], voffB[2];
#pragma unroll
    for (int i = 0; i < 2; ++i) { int R, C; stage_rc(tid * 16 + i * 8192, R, C); const int Rb = (R & ~31) + perm32(R & 31);
        voffA[i] = (unsigned)(R * pitchA + C) * 2u; voffB[i] = (unsigned)(Rb * pitchB + C) * 2u; }
    const size_t kstep = (size_t)(BK * 2);
    const size_t hstepA = (size_t)HALF * pitchA * 2, hstepB = (size_t)HALF * pitchB * 2;
    const unsigned ldsw = (unsigned)wid * 1024u;
    const int aoff = lds_byte(wr * 64 + fr, fq * 8), boff = lds_byte(wc * 32 + fr, fq * 8);
#define PG8_SA(b, h) (((b) * 2 + (h)) * HTB)
#define PG8_SB(b, h) ((4 + (b) * 2 + (h)) * HTB)
#define PG8_STAGE(bufoff, gbase, voff) do { _Pragma("unroll") for (int _i = 0; _i < 2; ++_i) \
        __builtin_amdgcn_global_load_lds((const unsigned*)((const char*)(gbase) + (voff)[_i]), (LAS unsigned*)(lds + (bufoff) + ldsw + _i * 8192), 16, 0, 0); } while (0)
#define PG8_LDA(dst, b, h) do { _Pragma("unroll") for (int m = 0; m < 4; ++m) _Pragma("unroll") for (int k = 0; k < 2; ++k) dst[m][k] = *(const LAS bf16x8*)(lds + PG8_SA(b, h) + aoff + m * 2048 + k * 1024); } while (0)
#define PG8_LDB(dst, b, h) do { _Pragma("unroll") for (int n = 0; n < 2; ++n) _Pragma("unroll") for (int k = 0; k < 2; ++k) dst[n][k] = *(const LAS bf16x8*)(lds + PG8_SB(b, h) + boff + n * 2048 + k * 1024); } while (0)
#define PG8_MMA(ai, bj, At, Bt) do { __builtin_amdgcn_s_setprio(1); _Pragma("unroll") for (int m = 0; m < 4; ++m) _Pragma("unroll") for (int n = 0; n < 2; ++n) _Pragma("unroll") for (int k = 0; k < 2; ++k) \
        acc[ai][bj][m][n] = __builtin_amdgcn_mfma_f32_16x16x32_bf16(Bt[n][k], At[m][k], acc[ai][bj][m][n], 0, 0, 0); __builtin_amdgcn_s_setprio(0); } while (0)
#define PG8_WAIT_V(n) asm volatile("s_waitcnt vmcnt(" #n ")" ::: "memory")
#define PG8_WAIT_L(n) asm volatile("s_waitcnt lgkmcnt(" #n ")" ::: "memory")
#define PG8_BAR __builtin_amdgcn_s_barrier()
#define PG8_SCHED __builtin_amdgcn_sched_barrier(0)
    Unit cur, nxt; int ui = 0;
    if (!S.next(0, cur)) return;
    f32x4 acc[2][2][4][2];
#pragma unroll
    for (int a = 0; a < 2; ++a)
#pragma unroll
        for (int b = 0; b < 2; ++b)
#pragma unroll
            for (int m = 0; m < 4; ++m)
#pragma unroll
                for (int n = 0; n < 2; ++n) acc[a][b][m][n] = (f32x4){0.f, 0.f, 0.f, 0.f};
    bf16x8 At[4][2], B0[2][2], B1[2][2];
    const char* cA = cur.A; const char* cB = cur.B;
    if constexpr (SP2) {
        PG8_STAGE(PG8_SB(0, 0), cB, voffB); PG8_STAGE(PG8_SB(0, 1), cB + hstepB, voffB); PG8_STAGE(PG8_SA(0, 0), cA, voffA); PG8_STAGE(PG8_SA(0, 1), cA + hstepA, voffA);
        if (wr == 1) PG8_BAR;
        PG8_WAIT_V(2); PG8_BAR;
        PG8_STAGE(PG8_SB(1, 0), cB + kstep, voffB); PG8_STAGE(PG8_SA(1, 0), cA + kstep, voffA); PG8_STAGE(PG8_SB(1, 1), cB + hstepB + kstep, voffB);
        PG8_WAIT_V(6); PG8_BAR;
    } else {
        PG8_STAGE(PG8_SB(0, 0), cB, voffB); PG8_STAGE(PG8_SA(0, 0), cA, voffA); PG8_STAGE(PG8_SB(0, 1), cB + hstepB, voffB); PG8_STAGE(PG8_SA(0, 1), cA + hstepA, voffA);
        if (wr == 1) PG8_BAR;
        PG8_WAIT_V(4); PG8_BAR;
        PG8_STAGE(PG8_SB(1, 0), cB + kstep, voffB); PG8_STAGE(PG8_SA(1, 0), cA + kstep, voffA); PG8_STAGE(PG8_SB(1, 1), cB + hstepB + kstep, voffB);
        PG8_WAIT_V(6); PG8_BAR;
    }
    for (;;) {
        const bool has_next = S.next(ui + 1, nxt);
        const char* nA = has_next ? nxt.A : cA; const char* nB = has_next ? nxt.B : cB;
        const int nt = cur.nt;
#pragma unroll 1
        for (int t = 0; t < nt; t += 2) {
            const bool last = (t == nt - 2);
            const char* a1 = cA + (size_t)(t + 1) * kstep;
            const char* a2 = last ? nA : cA + (size_t)(t + 2) * kstep; const char* b2 = last ? nB : cB + (size_t)(t + 2) * kstep;
            const char* a3 = a2 + kstep; const char* b3 = b2 + kstep;
            if constexpr (SP2) {
            PG8_LDB(B0, 0, 0); PG8_LDB(B1, 0, 1); PG8_SCHED; PG8_LDA(At, 0, 0); PG8_STAGE(PG8_SA(1, 1), a1 + hstepA, voffA);
            PG8_WAIT_V(8); PG8_WAIT_L(0); PG8_BAR; PG8_MMA(0, 0, At, B0); PG8_MMA(0, 1, At, B1); PG8_BAR; PG8_SCHED;
            PG8_LDA(At, 0, 1); PG8_STAGE(PG8_SB(0, 0), b2, voffB); PG8_STAGE(PG8_SB(0, 1), b2 + hstepB, voffB); PG8_STAGE(PG8_SA(0, 0), a2, voffA);
            PG8_WAIT_V(8); PG8_WAIT_L(0); PG8_BAR; PG8_MMA(1, 0, At, B0); PG8_MMA(1, 1, At, B1); PG8_BAR; PG8_SCHED;
            PG8_LDB(B0, 1, 0); PG8_LDB(B1, 1, 1); PG8_SCHED; PG8_LDA(At, 1, 0); PG8_STAGE(PG8_SA(0, 1), a2 + hstepA, voffA);
            PG8_WAIT_V(8); PG8_WAIT_L(0); PG8_BAR; PG8_MMA(0, 0, At, B0); PG8_MMA(0, 1, At, B1); PG8_BAR; PG8_SCHED;
            PG8_LDA(At, 1, 1); PG8_STAGE(PG8_SB(1, 0), b3, voffB); PG8_STAGE(PG8_SB(1, 1), b3 + hstepB, voffB); PG8_STAGE(PG8_SA(1, 0), a3, voffA);
            PG8_WAIT_V(8); PG8_WAIT_L(0); PG8_BAR; PG8_MMA(1, 0, At, B0); PG8_MMA(1, 1, At, B1); PG8_BAR; PG8_SCHED;
            } else {
            PG8_LDB(B0, 0, 0); PG8_SCHED; PG8_LDA(At, 0, 0); PG8_STAGE(PG8_SA(1, 1), a1 + hstepA, voffA);
            PG8_WAIT_L(8); PG8_BAR; PG8_WAIT_L(0); PG8_MMA(0, 0, At, B0); PG8_BAR; PG8_SCHED;
            PG8_LDB(B1, 0, 1); PG8_STAGE(PG8_SB(0, 0), b2, voffB);
            PG8_BAR; PG8_WAIT_L(0); PG8_MMA(0, 1, At, B1); PG8_BAR;
            PG8_LDA(At, 0, 1); PG8_STAGE(PG8_SA(0, 0), a2, voffA);
            PG8_BAR; PG8_WAIT_L(0); PG8_MMA(1, 0, At, B0); PG8_BAR; PG8_SCHED;
            PG8_STAGE(PG8_SB(0, 1), b2 + hstepB, voffB);
            PG8_WAIT_V(6); PG8_BAR; PG8_MMA(1, 1, At, B1); PG8_BAR;
            PG8_LDB(B0, 1, 0); PG8_SCHED; PG8_LDA(At, 1, 0); PG8_STAGE(PG8_SA(0, 1), a2 + hstepA, voffA);
            PG8_WAIT_L(8); PG8_BAR; PG8_WAIT_L(0); PG8_MMA(0, 0, At, B0); PG8_BAR; PG8_SCHED;
            PG8_LDB(B1, 1, 1); PG8_STAGE(PG8_SB(1, 0), b3, voffB);
            PG8_BAR; PG8_WAIT_L(0); PG8_MMA(0, 1, At, B1); PG8_BAR;
            PG8_LDA(At, 1, 1); PG8_STAGE(PG8_SA(1, 0), a3, voffA);
            PG8_BAR; PG8_WAIT_L(0); PG8_MMA(1, 0, At, B0); PG8_BAR; PG8_SCHED;
            PG8_STAGE(PG8_SB(1, 1), b3 + hstepB, voffB);
            PG8_WAIT_V(6); PG8_BAR; PG8_MMA(1, 1, At, B1); PG8_BAR;
            }
        }
        if constexpr (ALIGN_EPI) { if (wr == 0) PG8_BAR; }
        E(acc, cur, wr, wc, fr, fq);
        if (!has_next) break;
#pragma unroll
        for (int a = 0; a < 2; ++a)
#pragma unroll
            for (int b = 0; b < 2; ++b)
#pragma unroll
                for (int m = 0; m < 4; ++m)
#pragma unroll
                    for (int n = 0; n < 2; ++n) acc[a][b][m][n] = (f32x4){0.f, 0.f, 0.f, 0.f};
        cur = nxt; cA = nA; cB = nB; ++ui;
        if constexpr (ALIGN_EPI) { if (wr == 1) PG8_BAR; }
    }
    PG8_WAIT_V(0);
    if constexpr (!ALIGN_EPI) { if (wr == 0) PG8_BAR; }
    PG8_BAR;
#undef PG8_SA
#undef PG8_SB
#undef PG8_STAGE
#undef PG8_LDA
#undef PG8_LDB
#undef PG8_MMA
#undef PG8_WAIT_V
#undef PG8_WAIT_L
#undef PG8_BAR
#undef PG8_SCHED
}
}
using pg8::Unit;

struct Args { const float* in[21]; float* out; unsigned char* ws; };
struct Frame {
    LAS unsigned char* lds;
    int tid, lane, wave, vcu, G;
    const float* in[21]; float* out; unsigned char* ws;
};
typedef const __attribute__((address_space(4))) Args KArgs;
__device__ __forceinline__ Frame make_frame(LAS unsigned char* lds) {
    Frame F; F.lds = lds;
    F.tid = fresh_tid(); F.lane = F.tid & 63; F.wave = __builtin_amdgcn_readfirstlane(F.tid >> 6);
    F.G = gridDim.x; { const int bx = blockIdx.x; F.vcu = (F.G % 8 == 0) ? (bx % 8) * (F.G / 8) + bx / 8 : bx; }
    KArgs* ka = (KArgs*)__builtin_amdgcn_kernarg_segment_ptr(); asm volatile("" : "+s"(ka));
#pragma unroll
    for (int i = 0; i < 21; ++i) F.in[i] = ka->in[i];
    F.out = ka->out; F.ws = ka->ws;
    return F;
}
#define WSP(T, off) ((T*)(F.ws + (off)))

__device__ __forceinline__ void p0_transpose_item(const float* Wsrc  , int ldw, bf16_t* dst  , int ldt, LAS float* scr, int lane) {
    const int r = lane >> 4, c4 = lane & 15;
    f32x4 v[16];
#pragma unroll
    for (int i = 0; i < 16; ++i) v[i] = __builtin_nontemporal_load((const GAS f32x4*)(Wsrc + (size_t)(4 * i + r) * ldw + 4 * c4));
#pragma unroll
    for (int i = 0; i < 16; ++i) { LAS float* s = scr + (4 * i + r) * 65 + 4 * c4; s[0] = v[i].x; s[1] = v[i].y; s[2] = v[i].z; s[3] = v[i].w; }
    LDS_WAIT(); asm volatile("" ::: "memory");
    const int c = lane & 7;
#pragma unroll
    for (int j = 0; j < 8; ++j) { const int n = (lane >> 3) + 8 * j; const LAS float* s = scr + (8 * c) * 65 + n;
        u32x4 o; o.x = cvt_pk_bf16(s[0 * 65], s[1 * 65]); o.y = cvt_pk_bf16(s[2 * 65], s[3 * 65]); o.z = cvt_pk_bf16(s[4 * 65], s[5 * 65]); o.w = cvt_pk_bf16(s[6 * 65], s[7 * 65]);
        *(GAS u32x4*)(dst + (size_t)n * ldt + 8 * c) = o; }
    LDS_WAIT(); asm volatile("" ::: "memory");
}
__device__ __forceinline__ void rms_row_to_bf16(const float* xrow, const float* g, bf16_t* orow, int lane) {
    const GAS f32x4* xr = (const GAS f32x4*)xrow + lane;
    f32x4 v[16], gv[16]; float s = 0.f;
    const GAS f32x4* gr = (const GAS f32x4*)g + lane;
#pragma unroll
    for (int j = 0; j < 16; ++j) v[j] = __builtin_nontemporal_load(xr + 64 * j);
#pragma unroll
    for (int j = 0; j < 16; ++j) gv[j] = gr[64 * j];
#pragma unroll
    for (int j = 0; j < 16; ++j) s += (v[j].x * v[j].x + v[j].y * v[j].y) + (v[j].z * v[j].z + v[j].w * v[j].w);
    const float rstd = 1.0f / sqrtf(wave_sum(s) * (1.0f / DM) + EPS);
    GAS u32x2* o8 = (GAS u32x2*)orow + lane;
#pragma unroll
    for (int j = 0; j < 16; ++j) { const f32x4 gg = gv[j]; u32x2 w; w.x = cvt_pk_bf16(v[j].x * rstd * gg.x, v[j].y * rstd * gg.y); w.y = cvt_pk_bf16(v[j].z * rstd * gg.z, v[j].w * rstd * gg.w); o8[64 * j] = w; }
}
__device__ __forceinline__ int win_src_col(int np) { const int t = np >> 8, i = np & 255; return (t >= 12 && t < 24) ? ((i < 128) ? 3072 + 128 * (t - 12) + i : 4608 + 128 * (t - 12) + (i - 128)) : np; }

constexpr int I_IN = 64 * 152, I_KV = 64 * 16, I_OUT = 64 * 64, I_PW = 24 * 24, I_PL = 6 * 6;
constexpr int NITEMS_EARLY = I_IN + 2 * I_KV, NITEMS = NITEMS_EARLY + I_OUT + I_PW + 4 * I_PL;
__device__ __forceinline__ void p0_items(Frame& F, int first, int last, int gw, int NGW) {
    LAS float* scr = (LAS float*)(F.lds + F.wave * 16640);
    bf16_t* WIN = WSP(bf16_t, WS_WIN); bf16_t* WKV = WSP(bf16_t, WS_WKV); bf16_t* WOUT = WSP(bf16_t, WS_WOUT); bf16_t* WPW = WSP(bf16_t, WS_WPW); bf16_t* WPOOL = WSP(bf16_t, WS_WPOOL);
    for (int it = first + gw; it < last; it += NGW) {
        int r = it; const float* src; bf16_t* dst; int ldw, ldt;
        if (r < I_IN) { const int kb = r / 152, nb = r % 152; src = F.in[9] + (size_t)(64 * kb) * DIN + win_src_col(64 * nb); ldw = DIN; dst = WIN + (size_t)(64 * nb) * DM + 64 * kb; ldt = DM; }
        else if ((r -= I_IN) < I_KV) { const int kb = r / 16, nb = r % 16; src = F.in[10] + (size_t)(64 * kb) * DX + 64 * nb; ldw = DX; dst = WKV + (size_t)(64 * nb) * DM + 64 * kb; ldt = DM; }
        else if ((r -= I_KV) < I_KV) { const int kb = r / 16, nb = r % 16; src = F.in[11] + (size_t)(64 * kb) * DX + 64 * nb; ldw = DX; dst = WKV + (size_t)(1024 + 64 * nb) * DM + 64 * kb; ldt = DM; }
        else if ((r -= I_KV) < I_OUT) { const int kb = r / 64, nb = r % 64; src = F.in[19] + (size_t)(64 * kb) * DM + 64 * nb; ldw = DM; dst = WOUT + (size_t)(64 * nb) * DM + 64 * kb; ldt = DM; }
        else if ((r -= I_OUT) < I_PW) { const int kb = r / 24, nb = r % 24; src = F.in[18] + (size_t)(64 * kb) * DCONV + 64 * nb; ldw = DCONV; dst = WPW + (size_t)(64 * nb) * DCONV + 64 * kb; ldt = DCONV; }
        else { r -= I_PW; const int g = r / I_PL, q = r % I_PL, kb = q / 6, nb = q % 6;
            src = F.in[12] + (size_t)g * PGRP * PGRP + (size_t)(64 * kb) * PGRP + 64 * nb; ldw = PGRP; dst = WPOOL + (size_t)g * 512 * PGRP + (size_t)(64 * nb) * PGRP + 64 * kb; ldt = PGRP; }
        p0_transpose_item(src, ldw, dst, ldt, scr, F.lane);
    }
}
__device__ __forceinline__ void p0_pool_pad(Frame& F, int gt, int NGT) {
    bf16_t* WPOOL = WSP(bf16_t, WS_WPOOL);
    for (int i = gt; i < 4 * 6144; i += NGT) { const int g = i / 6144, q = i % 6144; *(GAS u32x4*)(WPOOL + (size_t)g * 512 * PGRP + (size_t)384 * PGRP + (size_t)q * 8) = (u32x4){0u, 0u, 0u, 0u}; }
}
__device__ __forceinline__ void p0_pool_frag(Frame& F, int gt, int NGT) {
    bf16_t* WF = WSP(bf16_t, WS_WPOOLF);
    for (int i = gt; i < 4 * 24 * 12 * 64; i += NGT) { const int l = i & 63, blk = i >> 6, ks = blk % 12, nt = (blk / 12) % 24, g = blk / 288;
        const float* src = F.in[12] + (size_t)g * PGRP * PGRP + (size_t)(32 * ks + 8 * (l >> 4)) * PGRP + 16 * nt + (l & 15);
        float v[8];
#pragma unroll
        for (int e = 0; e < 8; ++e) v[e] = *(const GAS float*)(src + (size_t)e * PGRP);
        *(GAS u32x4*)(WF + (size_t)i * 8) = (u32x4){cvt_pk_bf16(v[0], v[1]), cvt_pk_bf16(v[2], v[3]), cvt_pk_bf16(v[4], v[5]), cvt_pk_bf16(v[6], v[7])}; }
}
__device__ __forceinline__ void p0_prologue(Frame& F, bool all_weights) {
    const int gw = F.vcu * NWAVES + F.wave, NGW = F.G * NWAVES;
    p0_items(F, 0, all_weights ? NITEMS : NITEMS_EARLY, gw, NGW);
    if (all_weights) { p0_pool_pad(F, F.vcu * NTHR + F.tid, F.G * NTHR); p0_pool_frag(F, F.vcu * NTHR + F.tid, F.G * NTHR); }
    bf16_t* H = WSP(bf16_t, WS_H); bf16_t* HM = WSP(bf16_t, WS_HM);
    for (int m = gw; m < MT + MM; m += NGW) {
        if (m < MP) rms_row_to_bf16(F.in[0] + (size_t)m * DM, F.in[7], H + (size_t)m * DM, F.lane);
        else if (m < MT) rms_row_to_bf16(F.in[2] + (size_t)(m - MP) * DM, F.in[7], H + (size_t)m * DM, F.lane);
        else rms_row_to_bf16(F.in[1] + (size_t)(m - MT) * DM, F.in[8], HM + (size_t)(m - MT) * DM, F.lane);
    }
}

constexpr int G1_NM = MT / 256, G1_NN = DIN / 256, G1_IN = G1_NM * G1_NN, G1_ALL = G1_IN + 48;
constexpr size_t TSTEP4K = (size_t)256 * DM * 2;
constexpr int G1_SPECIAL = 16, G1_PROMPT = (MP / 256) * G1_NN, G1_S2 = 60;
struct Sched1 {
    int G, c; const char *H, *HM, *WIN, *WKV;
    __device__ __forceinline__ bool next(int i, Unit& u) const {
        int L = i * G + c; if (L >= G1_ALL) return false;
        u.nt = DM / 64; u.kind = 0;
        if (L < G1_SPECIAL) { u.pm = MP / 256 + (L >> 3); u.pn = 30 + (L & 7); u.kind = 4; }
        else if ((L -= G1_SPECIAL) < G1_PROMPT) { int pm, pn; pg8::tile_order(L, MP / 256, G1_NN, pm, pn); u.pm = pm; u.pn = pn; }
        else if ((L -= G1_PROMPT) < G1_S2) { u.pm = MP / 256 + L / 30; u.pn = L % 30; }
        else { const int r = L - G1_S2, t = r >> 4, pm = (r >> 2) & 3, pn = r & 3; u.pm = pm; u.pn = pn; u.kind = 1 + t;
            if (t == 0) { u.A = HM + (size_t)pm * TSTEP4K; u.B = WKV + (size_t)pn * TSTEP4K; }
            else if (t == 1) { u.A = HM + (size_t)pm * TSTEP4K; u.B = WKV + (size_t)(4 + pn) * TSTEP4K; }
            else { u.A = WKV + (size_t)(4 + pm) * TSTEP4K; u.B = HM + (size_t)pn * TSTEP4K; }
            return true; }
        u.A = H + (size_t)u.pm * TSTEP4K; u.B = WIN + (size_t)u.pn * TSTEP4K;
        return true;
    }
};
struct Epi1 {
    bf16_t *U, *SGA, *A, *SGB, *Q, *SGC, *KP, *VPT; float *outK, *outV; unsigned* qready;
    __device__ __forceinline__ void operator()(const f32x4 (&acc)[2][2][4][2], const Unit& u, int wr, int wc, int fr, int fq) const {
        const int row0 = u.pm * 256 + wr * 64 + fr, cl = wc * 32 + 8 * fq;
        if (u.kind == 0 || u.kind == 4) {
            const int pn = u.pn;
            if (pn >= 12 && pn < 24) {
                bf16_t* base = A + (size_t)row0 * DCONV + (pn - 12) * 128 + cl;
#pragma unroll
                for (int ai = 0; ai < 2; ++ai)
#pragma unroll
                    for (int m = 0; m < 4; ++m) { const f32x4 v0 = acc[ai][0][m][0], v1 = acc[ai][0][m][1], g0 = acc[ai][1][m][0], g1 = acc[ai][1][m][1];
                        u32x4 w; w.x = cvt_pk_bf16(v0[0] * fast_sigmoid(g0[0]), v0[1] * fast_sigmoid(g0[1])); w.y = cvt_pk_bf16(v0[2] * fast_sigmoid(g0[2]), v0[3] * fast_sigmoid(g0[3]));
                        w.z = cvt_pk_bf16(v1[0] * fast_sigmoid(g1[0]), v1[1] * fast_sigmoid(g1[1])); w.w = cvt_pk_bf16(v1[2] * fast_sigmoid(g1[2]), v1[3] * fast_sigmoid(g1[3]));
                        *(u32x4*)(base + (size_t)(ai * 128 + m * 16) * DCONV) = w; }
            } else {
                bf16_t* dst; int ldc, colt; bool act;
                if (pn < 6) { dst = U; ldc = DPOOL; colt = pn * 256; act = false; }
                else if (pn < 12) { dst = SGA; ldc = DPOOL; colt = (pn - 6) * 256; act = true; }
                else if (pn < 30) { dst = SGB; ldc = DCONV; colt = (pn - 24) * 256; act = true; }
                else if (pn < 34) { dst = Q; ldc = DX; colt = (pn - 30) * 256; act = false; }
                else { dst = SGC; ldc = DX; colt = (pn - 34) * 256; act = true; }
                bf16_t* base = dst + (size_t)row0 * ldc + colt + cl;
#pragma unroll
                for (int ai = 0; ai < 2; ++ai)
#pragma unroll
                    for (int m = 0; m < 4; ++m)
#pragma unroll
                        for (int bj = 0; bj < 2; ++bj) { f32x4 v0 = acc[ai][bj][m][0], v1 = acc[ai][bj][m][1];
                            if (act) {
#pragma unroll
                                for (int j = 0; j < 4; ++j) { v0[j] = fast_silu(v0[j]); v1[j] = fast_silu(v1[j]); } }
                            u32x4 w; w.x = cvt_pk_bf16(v0[0], v0[1]); w.y = cvt_pk_bf16(v0[2], v0[3]); w.z = cvt_pk_bf16(v1[0], v1[1]); w.w = cvt_pk_bf16(v1[2], v1[3]);
                            *(u32x4*)(base + (size_t)(ai * 128 + m * 16) * ldc + bj * 128) = w; }
            }
        } else if (u.kind == 3) {
            bf16_t* base = VPT + (size_t)row0 * 1024 + u.pn * 256 + cl;
#pragma unroll
            for (int ai = 0; ai < 2; ++ai)
#pragma unroll
                for (int m = 0; m < 4; ++m)
#pragma unroll
                    for (int bj = 0; bj < 2; ++bj) { const f32x4 v0 = acc[ai][bj][m][0], v1 = acc[ai][bj][m][1];
                        u32x4 w; w.x = cvt_pk_bf16(v0[0], v0[1]); w.y = cvt_pk_bf16(v0[2], v0[3]); w.z = cvt_pk_bf16(v1[0], v1[1]); w.w = cvt_pk_bf16(v1[2], v1[3]);
                        *(u32x4*)(base + (size_t)(ai * 128 + m * 16) * 1024 + bj * 128) = w; }
        } else {
            float* fb = (u.kind == 1 ? outK : outV) + (size_t)row0 * 1024 + u.pn * 256 + cl;
            bf16_t* kb = KP + (size_t)row0 * 1024 + u.pn * 256 + cl;
            const bool wk = (u.kind == 1);
#pragma unroll
            for (int ai = 0; ai < 2; ++ai)
#pragma unroll
                for (int m = 0; m < 4; ++m)
#pragma unroll
                    for (int bj = 0; bj < 2; ++bj) { const f32x4 v0 = acc[ai][bj][m][0], v1 = acc[ai][bj][m][1];
                        float* p = fb + (size_t)(ai * 128 + m * 16) * 1024 + bj * 128; *(f32x4*)p = v0; *(f32x4*)(p + 4) = v1;
                        if (wk) { u32x4 w; w.x = cvt_pk_bf16(v0[0], v0[1]); w.y = cvt_pk_bf16(v0[2], v0[3]); w.z = cvt_pk_bf16(v1[0], v1[1]); w.w = cvt_pk_bf16(v1[2], v1[3]);
                            *(u32x4*)(kb + (size_t)(ai * 128 + m * 16) * 1024 + bj * 128) = w; } }
        }
        if (u.kind == 4) {
            asm volatile("s_waitcnt vmcnt(0)" ::: "memory"); __builtin_amdgcn_s_barrier(); asm volatile("" ::: "memory");
            if (threadIdx.x == 0) { __builtin_amdgcn_fence(__ATOMIC_RELEASE, "agent"); asm volatile("s_waitcnt vmcnt(0)" ::: "memory");
                __hip_atomic_fetch_add(qready, 1u, __ATOMIC_RELAXED, __HIP_MEMORY_SCOPE_AGENT); } }
    }
};

__device__ __forceinline__ f32x4 ld_bf4(const bf16_t* p) { const u32x2 w = *(const GAS u32x2*)p; return (f32x4){bf_lo(w.x), bf_hi(w.x), bf_lo(w.y), bf_hi(w.y)}; }
__device__ __forceinline__ void states_copy_rows(Frame& F, int gw, int NGW) {
    constexpr int KP_ = PSTATE - DS, KC_ = CSTATE - DS, R_P = DB * KP_, R_C = DB * KC_;
    const unsigned ln = (unsigned)F.lane;
    for (int i = gw; i < R_P + R_C; i += NGW) {
        const float* sf; float* dst;
        if (i < R_P) { const int b = i / KP_, j = i % KP_; sf = F.in[5] + (size_t)(b * PSTATE + j + DS) * DPOOL; dst = F.out + O_PSS + (size_t)(b * PSTATE + j) * DPOOL; }
        else { const int r = i - R_P, b = r / KC_, j = r % KC_; sf = F.in[6] + (size_t)(b * CSTATE + j + DS) * DCONV; dst = F.out + O_CSS + (size_t)(b * CSTATE + j) * DCONV; }
        f32x4 v[6];
#pragma unroll
        for (int k = 0; k < 6; ++k) v[k] = ldg<f32x4>(sf, (256u * k + 4u * ln) * 4u);
#pragma unroll
        for (int k = 0; k < 6; ++k) *(GAS f32x4*)((char*)dst + (256u * k + 4u * ln) * 4u) = v[k];
    }
}
__device__ __forceinline__ void p2_states(Frame& F) {
    const bf16_t* U = WSP(bf16_t, WS_U); const bf16_t* A = WSP(bf16_t, WS_A);
    constexpr int R_PSP = NB * PSTATE, R_CSP = NB * CSTATE, R_S = DB * DS;
    const unsigned ln = (unsigned)F.lane;
    for (int i = F.vcu * NWAVES + F.wave; i < R_PSP + R_CSP + 2 * R_S; i += F.G * NWAVES) {
        int r = i; const bf16_t* sb; float* dst;
        if (r < R_PSP) { const int j = r % PSTATE, b = r / PSTATE; sb = U + (size_t)(b * SEQ + SEQ - PSTATE + j) * DPOOL; dst = F.out + O_PSP + (size_t)r * DPOOL; }
        else if ((r -= R_PSP) < R_CSP) { const int j = r % CSTATE, b = r / CSTATE; sb = A + (size_t)(b * SEQ + SEQ - CSTATE + j) * DCONV; dst = F.out + O_CSP + (size_t)r * DCONV; }
        else if ((r -= R_CSP) < R_S) { const int b = r >> 2, t = r & 3; sb = U + (size_t)(MP + r) * DPOOL; dst = F.out + O_PSS + (size_t)(b * PSTATE + PSTATE - DS + t) * DPOOL; }
        else { r -= R_S; const int b = r >> 2, t = r & 3; sb = A + (size_t)(MP + r) * DCONV; dst = F.out + O_CSS + (size_t)(b * CSTATE + CSTATE - DS + t) * DCONV; }
        f32x4 v[6];
#pragma unroll
        for (int k = 0; k < 6; ++k) { const u32x2 w = ldg<u32x2>(sb, (256u * k + 4u * ln) * 2u); v[k] = (f32x4){bf_lo(w.x), bf_hi(w.x), bf_lo(w.y), bf_hi(w.y)}; }
#pragma unroll
        for (int k = 0; k < 6; ++k) *(GAS f32x4*)((char*)dst + (256u * k + 4u * ln) * 4u) = v[k];
    }
}
template <int W, bool SAMPLE> __device__ __forceinline__ void pool_task(Frame& F, int r0  , int c  , size_t src_off = WS_U, size_t dst_off = WS_POOLED) {
    const bf16_t* U = WSP(bf16_t, src_off); bf16_t* P = WSP(bf16_t, dst_off);
    constexpr bool sample = SAMPLE;
    const int pos0 = sample ? 0 : (r0 & (SEQ - 1));
    const int bs = (r0 - MP) >> 2;
    float x[W + 3][8];
#pragma unroll
    for (int i = 0; i < W + 3; ++i) {
        const int rr = i - (W - 1);
        if (rr >= 0 || (!sample && pos0 + rr >= 0)) { const u32x4 w = *(const GAS u32x4*)(U + (size_t)(r0 + rr) * DPOOL + c);
            x[i][0] = bf_lo(w.x); x[i][1] = bf_hi(w.x); x[i][2] = bf_lo(w.y); x[i][3] = bf_hi(w.y); x[i][4] = bf_lo(w.z); x[i][5] = bf_hi(w.z); x[i][6] = bf_lo(w.w); x[i][7] = bf_hi(w.w); }
        else if (sample) { const float* sp = F.in[5] + ((size_t)bs * PSTATE + (PSTATE + rr)) * DPOOL + c; const f32x4 a = *(const GAS f32x4*)sp, b = *(const GAS f32x4*)(sp + 4);
            x[i][0] = a.x; x[i][1] = a.y; x[i][2] = a.z; x[i][3] = a.w; x[i][4] = b.x; x[i][5] = b.y; x[i][6] = b.z; x[i][7] = b.w; }
        else {
#pragma unroll
            for (int e = 0; e < 8; ++e) x[i][e] = 0.f; }
    }
#pragma unroll
    for (int tk = 0; tk < 4; ++tk) {
        float s[8];
#pragma unroll
        for (int e = 0; e < 8; ++e) s[e] = 0.f;
#pragma unroll
        for (int i = 0; i < W; ++i)
#pragma unroll
            for (int e = 0; e < 8; ++e) s[e] += x[tk + i][e];
        const int pos = pos0 + tk; const float inv = sample ? (1.0f / W) : 1.0f / (float)((pos + 1 < W) ? pos + 1 : W);
        u32x4 o; o.x = cvt_pk_bf16(s[0] * inv - x[tk + W - 1][0], s[1] * inv - x[tk + W - 1][1]); o.y = cvt_pk_bf16(s[2] * inv - x[tk + W - 1][2], s[3] * inv - x[tk + W - 1][3]);
        o.z = cvt_pk_bf16(s[4] * inv - x[tk + W - 1][4], s[5] * inv - x[tk + W - 1][5]); o.w = cvt_pk_bf16(s[6] * inv - x[tk + W - 1][6], s[7] * inv - x[tk + W - 1][7]);
        *(GAS u32x4*)(P + (size_t)(r0 + tk) * DPOOL + c) = o;
    }
}
__device__ __forceinline__ void p2_pool_sample_task(Frame& F, int sidx) {
    const int R0 = (256 + sidx / 24) * 32, id = sidx % 24, g = id / 6, q = id % 6, third = q >> 1, half = q & 1;
    const int r0 = R0 + 16 * half + 4 * (F.lane >> 4), c = g * PGRP + third * 128 + (F.lane & 15) * 8;
    if (g == 0) pool_task<2, true>(F, r0, c); else if (g == 1) pool_task<4, true>(F, r0, c); else if (g == 2) pool_task<8, true>(F, r0, c); else pool_task<16, true>(F, r0, c);
}
constexpr int PL_ROWS = 32 + PSTATE, PL_STAGE = PL_ROWS * DPOOL * 2;
__device__ __forceinline__ void lds_row8(const LAS unsigned char* p, float (&x)[8]) { const u32x4 w = *(const LAS u32x4*)p;
    x[0] = bf_lo(w.x); x[1] = bf_hi(w.x); x[2] = bf_lo(w.y); x[3] = bf_hi(w.y); x[4] = bf_lo(w.z); x[5] = bf_hi(w.z); x[6] = bf_lo(w.w); x[7] = bf_hi(w.w); }
__device__ __forceinline__ void p2_pool_unit_prompt(Frame& F, int unit, int sidx = -1) {
    LAS unsigned char* S = F.lds;
    const bf16_t* U = WSP(bf16_t, WS_U); bf16_t* P = WSP(bf16_t, WS_POOLED);
    unsigned tid = (unsigned)F.tid; asm volatile("" : "+v"(tid));
    const unsigned ln = tid & 63u;
    const int R0 = unit * 32, pos_u = (unit & 63) * 32;
#pragma unroll 1
    for (int i = F.wave; i < PL_ROWS * 3; i += NWAVES) { const int row = i / 3, th = i - 3 * row, rel = row - PSTATE;
        if (pos_u + rel >= 0) __builtin_amdgcn_global_load_lds((const unsigned*)((const char*)(U + (size_t)(R0 + rel) * DPOOL) + th * 1024 + ln * 16u), (LAS unsigned*)(S + i * 1024), 16, 0, 0);
        else *(LAS u32x4*)(S + i * 1024 + ln * 16u) = (u32x4){0u, 0u, 0u, 0u}; }
    if (sidx >= 0 && sidx < 16 * 24) p2_pool_sample_task(F, sidx);
    asm volatile("s_waitcnt vmcnt(0) lgkmcnt(0)" ::: "memory"); __syncthreads();
#pragma unroll 1
    for (int k = 0; k < 3; ++k) { const unsigned id = tid + 512u * k, co = id % 192u, tg = id / 192u, g = co / 48u; const int W = 2 << g;
        const LAS unsigned char* base = S + co * 16u + (PSTATE + 4 * tg) * (DPOOL * 2);
        float s[8], x[8];
#pragma unroll
        for (int e = 0; e < 8; ++e) s[e] = 0.f;
        for (int i = 0; i < W; ++i) { lds_row8(base - i * (DPOOL * 2), x);
#pragma unroll
            for (int e = 0; e < 8; ++e) s[e] += x[e]; }
#pragma unroll
        for (int tk = 0; tk < 4; ++tk) {
            if (tk > 0) { float a[8], b[8]; lds_row8(base + tk * (DPOOL * 2), a); lds_row8(base + (tk - W) * (DPOOL * 2), b);
#pragma unroll
                for (int e = 0; e < 8; ++e) s[e] += a[e] - b[e]; }
            lds_row8(base + tk * (DPOOL * 2), x);
            const int pos = pos_u + 4 * (int)tg + tk; const float inv = 1.0f / (float)((pos + 1 < W) ? pos + 1 : W);
            u32x4 o; o.x = cvt_pk_bf16(s[0] * inv - x[0], s[1] * inv - x[1]); o.y = cvt_pk_bf16(s[2] * inv - x[2], s[3] * inv - x[3]);
            o.z = cvt_pk_bf16(s[4] * inv - x[4], s[5] * inv - x[5]); o.w = cvt_pk_bf16(s[6] * inv - x[6], s[7] * inv - x[7]);
            *(GAS u32x4*)((char*)(P + (size_t)(R0 + 4 * tg + tk) * DPOOL) + co * 16u) = o; }
    }
    LDS_WAIT(); __syncthreads();
}
constexpr int PMS_ROWS = 128 + PSTATE, PMS_PITCH = 1024;
__device__ __forceinline__ void poolmix_stage(Frame& F, int unit) {
    LAS unsigned char* S = F.lds; const bf16_t* U = WSP(bf16_t, WS_U);
    const int g = unit & 3, rb = unit >> 2, R0 = rb * 128, pos_u = (rb & 15) * 128;
    unsigned ln = (unsigned)F.lane; asm volatile("" : "+v"(ln));
#pragma unroll 1
    for (int row = F.wave; row < PMS_ROWS; row += NWAVES) { const int rel = row - PSTATE;
        if (pos_u + rel >= 0) __builtin_amdgcn_global_load_lds((const unsigned*)((const char*)(U + (size_t)(R0 + rel) * DPOOL + g * PGRP) + ln * 16u), (LAS unsigned*)(S + row * PMS_PITCH), 16, 0, 0);
        else { unsigned zz = 0u; asm volatile("" : "+v"(zz)); *(LAS u32x4*)(S + row * PMS_PITCH + ln * 16u) = (u32x4){zz, zz, zz, zz}; } }
}
constexpr int PM_ROWS = 128 + PSTATE, PM_PITCH = 1024, PM_PLP = 784;
__device__ __forceinline__ void p2_poolmix_unit(Frame& F, int unit, bool staged = false) {
    LAS unsigned char* S = F.lds;
    const bf16_t* U = WSP(bf16_t, WS_U); const bf16_t* WF = WSP(bf16_t, WS_WPOOLF); const bf16_t* SGA = WSP(bf16_t, WS_SGA); bf16_t* CAT = WSP(bf16_t, WS_CAT);
    const int g = unit & 3, rb = unit >> 2, R0 = rb * 128, pos_u = (rb & 15) * 128;
    unsigned tid = (unsigned)F.tid; asm volatile("" : "+v"(tid));
    const unsigned ln = tid & 63u, fr = ln & 15u, fq = ln >> 4;
    if (!staged) poolmix_stage(F, unit);
    const int n0 = 48 * F.wave;
    constexpr int NKS = PGRP / 32, DEPTH = 3, PM_PO = PGRP * 4 + 16;
    const bf16_t* wb = WF + (size_t)((g * 24 + 3 * F.wave) * NKS) * 512;
    const unsigned woff = ln * 16u;
    bf16x8 bq[DEPTH][3]; u32x4 gts[6]; f32x4 ps[3];
#pragma unroll
    for (int d = 0; d < DEPTH; ++d)
#pragma unroll
        for (int j = 0; j < 3; ++j) bq[d][j] = ldg<bf16x8>(wb + (size_t)(j * NKS + d) * 512, woff);
    asm volatile("s_waitcnt vmcnt(0) lgkmcnt(0)" ::: "memory"); __syncthreads();
    const int W = 2 << g;
    u32x4 pv[3][4];
#pragma unroll
    for (int k = 0; k < 3; ++k) { const unsigned id = tid + 512u * k, co = id % 48u, tg = id / 48u;
        const LAS unsigned char* base = S + co * 16u + (PSTATE + 4 * tg) * PM_PITCH;
        float s[8], x[8];
#pragma unroll
        for (int e = 0; e < 8; ++e) s[e] = 0.f;
        for (int i = 0; i < W; ++i) { lds_row8(base - i * PM_PITCH, x);
#pragma unroll
            for (int e = 0; e < 8; ++e) s[e] += x[e]; }
#pragma unroll
        for (int tk = 0; tk < 4; ++tk) {
            if (tk > 0) { float a[8], b[8]; lds_row8(base + tk * PM_PITCH, a); lds_row8(base + (tk - W) * PM_PITCH, b);
#pragma unroll
                for (int e = 0; e < 8; ++e) s[e] += a[e] - b[e]; }
            lds_row8(base + tk * PM_PITCH, x);
            const int pos = pos_u + 4 * (int)tg + tk; const float inv = 1.0f / (float)((pos + 1 < W) ? pos + 1 : W);
            u32x4 o; o.x = cvt_pk_bf16(s[0] * inv - x[0], s[1] * inv - x[1]); o.y = cvt_pk_bf16(s[2] * inv - x[2], s[3] * inv - x[3]);
            o.z = cvt_pk_bf16(s[4] * inv - x[4], s[5] * inv - x[5]); o.w = cvt_pk_bf16(s[6] * inv - x[6], s[7] * inv - x[7]);
            pv[k][tk] = o; }
    }
    LDS_WAIT(); __syncthreads();
#pragma unroll
    for (int k = 0; k < 3; ++k) { const unsigned id = tid + 512u * k, co = id % 48u, tg = id / 48u;
#pragma unroll
        for (int tk = 0; tk < 4; ++tk) *(LAS u32x4*)(S + (4 * tg + tk) * PM_PLP + co * 16u) = pv[k][tk]; }
    LDS_WAIT(); __syncthreads();
    f32x4 acc[8][3];
#pragma unroll
    for (int mi = 0; mi < 8; ++mi)
#pragma unroll
        for (int j = 0; j < 3; ++j) acc[mi][j] = (f32x4){0.f, 0.f, 0.f, 0.f};
#pragma unroll
    for (int j = 0; j < 3; ++j) ps[j] = ldg<f32x4>(F.in[13], ((unsigned)(g * PGRP + n0 + 16 * j) + 4u * fq) * 4u);
    const LAS unsigned char* ap = S + fr * PM_PLP + fq * 16u;
    bf16x8 an[4];
#pragma unroll
    for (int m = 0; m < 4; ++m) an[m] = *(const LAS bf16x8*)(ap + (16 * m) * PM_PLP);
#pragma unroll
    for (int ks = 0; ks < NKS; ++ks) {
        bf16x8 bc[3];
#pragma unroll
        for (int j = 0; j < 3; ++j) bc[j] = bq[ks % DEPTH][j];
        if (ks + DEPTH < NKS) {
#pragma unroll
            for (int j = 0; j < 3; ++j) bq[ks % DEPTH][j] = ldg<bf16x8>(wb + (size_t)(j * NKS + ks + DEPTH) * 512, woff); }
#pragma unroll
        for (int h = 0; h < 2; ++h) { bf16x8 a[4];
#pragma unroll
            for (int m = 0; m < 4; ++m) a[m] = an[m];
            const int hn = (h + 1) & 1, kn = ks + (h == 1 ? 1 : 0);
            if (kn < NKS) {
#pragma unroll
                for (int m = 0; m < 4; ++m) an[m] = *(const LAS bf16x8*)(ap + (16 * (4 * hn + m)) * PM_PLP + 64 * kn); }
#pragma unroll
            for (int m = 0; m < 4; ++m)
#pragma unroll
                for (int j = 0; j < 3; ++j) acc[4 * h + m][j] = __builtin_amdgcn_mfma_f32_16x16x32_bf16(bc[j], a[m], acc[4 * h + m][j], 0, 0, 0); }
    }
    unsigned t2 = tid; asm volatile("" : "+v"(t2));
#pragma unroll
    for (int h = 0; h < 2; ++h) {
#pragma unroll
        for (int k = 0; k < 6; ++k) { const unsigned id = t2 + 512u * k, row = id / 48u, c8 = id % 48u;
            gts[k] = ldg<u32x4>(SGA + (size_t)(R0 + 64 * h) * DPOOL + g * PGRP, (row * (unsigned)DPOOL + 8u * c8) * 2u); }
        LDS_WAIT(); __syncthreads();
#pragma unroll
        for (int m = 0; m < 4; ++m)
#pragma unroll
            for (int j = 0; j < 3; ++j) *(LAS f32x4*)(S + (16 * m + fr) * PM_PO + (n0 + 16 * j + 4 * fq) * 4) = acc[4 * h + m][j] * ps[j];
        LDS_WAIT(); __syncthreads();
#pragma unroll
        for (int k = 0; k < 6; ++k) { const unsigned id = t2 + 512u * k, row = id / 48u, c8 = id % 48u;
            const f32x4 v0 = *(const LAS f32x4*)(S + row * PM_PO + c8 * 32u), v1 = *(const LAS f32x4*)(S + row * PM_PO + c8 * 32u + 16u); const u32x4 gg = gts[k];
            u32x4 w; w.x = cvt_pk_bf16(v0[0] * bf_lo(gg.x), v0[1] * bf_hi(gg.x)); w.y = cvt_pk_bf16(v0[2] * bf_lo(gg.y), v0[3] * bf_hi(gg.y));
            w.z = cvt_pk_bf16(v1[0] * bf_lo(gg.z), v1[1] * bf_hi(gg.z)); w.w = cvt_pk_bf16(v1[2] * bf_lo(gg.w), v1[3] * bf_hi(gg.w));
            *(GAS u32x4*)((char*)(CAT + (size_t)(R0 + 64 * h + row) * DM + g * PGRP) + c8 * 16u) = w; }
    }
    LDS_WAIT(); __syncthreads();
}
template <bool SAMPLE, int NSEGS = 4> __device__ __forceinline__ void conv_block16(Frame& F, int rowA, const f32x2 (&wp)[CW], const float (&wq)[CW], f32x2 bp, float bq, LAS float* Y) {
    const bf16_t* A = WSP(bf16_t, WS_A);
    unsigned ln = (unsigned)F.lane; asm volatile("" : "+v"(ln));
    const unsigned p = 192u * (unsigned)F.wave + 2u * ln, q = 192u * (unsigned)F.wave + 128u + ln;
    constexpr int NT = SAMPLE ? 4 : 16, NSEG = SAMPLE ? NSEGS : 1, NR = NT + CW - 1, GS = 8, NG = (NR + GS - 1) / GS;
#pragma unroll
    for (int seg = 0; seg < NSEG; ++seg) {
        const int r0 = rowA + seg * NT;
        const int pos0 = SAMPLE ? 0 : (r0 & (SEQ - 1));
        const int bs = (r0 - MP) >> 2;
        f32x2 ap[NT]; float aq[NT];
#pragma unroll
        for (int t = 0; t < NT; ++t) { ap[t] = bp; aq[t] = bq; }
        f32x2 vp[3][GS]; float vq[3][GS];
#define CONV_LOAD(gi) do { _Pragma("unroll") for (int i = 0; i < GS; ++i) { const int rr = (gi) * GS + i; const int rel = rr - (CW - 1); \
            if (rr >= NR) { vp[(gi) % 3][i] = (f32x2){0.f, 0.f}; vq[(gi) % 3][i] = 0.f; } \
            else if (SAMPLE && rel < 0) { const float* sp = F.in[6] + ((size_t)bs * CSTATE + (CSTATE + rel)) * DCONV; vp[(gi) % 3][i] = ldg<f32x2>(sp, p * 4u); vq[(gi) % 3][i] = ldg<float>(sp, q * 4u); } \
            else if (SAMPLE || pos0 + rel >= 0) { const bf16_t* ar = A + (size_t)(r0 + rel) * DCONV; const unsigned w2 = ldg<unsigned>(ar, p * 2u); const unsigned w1 = ldg<unsigned short>(ar, q * 2u); \
                vp[(gi) % 3][i] = (f32x2){bf_lo(w2), bf_hi(w2)}; vq[(gi) % 3][i] = bf_lo(w1); } \
            else { vp[(gi) % 3][i] = (f32x2){0.f, 0.f}; vq[(gi) % 3][i] = 0.f; } } } while (0)
        CONV_LOAD(0); if (NG > 1) CONV_LOAD(1);
#pragma unroll
        for (int gi = 0; gi < NG; ++gi) {
            if (gi + 2 < NG) CONV_LOAD(gi + 2);
#pragma unroll
            for (int i = 0; i < GS; ++i) { const int rr = gi * GS + i;
#pragma unroll
                for (int t = 0; t < NT; ++t) { const int j = rr - t; if (rr < NR && j >= 0 && j < CW) { ap[t] += wp[j] * vp[gi % 3][i]; aq[t] += wq[j] * vq[gi % 3][i]; } } }
            __builtin_amdgcn_sched_barrier(0);
        }
#undef CONV_LOAD
#pragma unroll
        for (int t = 0; t < NT; ++t) { *(LAS f32x2*)(Y + (seg * NT + t) * DCONV + p) = ap[t]; Y[(seg * NT + t) * DCONV + q] = aq[t]; }
    }
}
__device__ __forceinline__ void conv_norm16(Frame& F, int rowA, const LAS float* Y, int ntok = 16) {
    bf16_t* CACT = WSP(bf16_t, WS_CACT);
    unsigned ln = (unsigned)F.lane; asm volatile("" : "+v"(ln));
#pragma unroll
    for (int tt = 0; tt < 2; ++tt) { const int t = 2 * F.wave + tt; if (t >= ntok) break;
        f32x4 y[6]; float s = 0.f;
#pragma unroll
        for (int k = 0; k < 6; ++k) { y[k] = *(const LAS f32x4*)(Y + t * DCONV + 256 * k + 4 * ln); s += (y[k][0] + y[k][1]) + (y[k][2] + y[k][3]); }
        const float mean = wave_sum(s) * (1.0f / DCONV); float qq = 0.f;
#pragma unroll
        for (int k = 0; k < 6; ++k) { y[k] = y[k] - mean; qq += (y[k][0] * y[k][0] + y[k][1] * y[k][1]) + (y[k][2] * y[k][2] + y[k][3] * y[k][3]); }
        const float rstd = 1.0f / sqrtf(wave_sum(qq) * (1.0f / DCONV) + EPS);
        f32x4 gk[6], bk[6];
#pragma unroll
        for (int k = 0; k < 6; ++k) { const unsigned c = 256u * k + 4u * ln; gk[k] = ldg<f32x4>(F.in[16], c * 4u); bk[k] = ldg<f32x4>(F.in[17], c * 4u); }
#pragma unroll
        for (int k = 0; k < 6; ++k) { const unsigned c = 256u * k + 4u * ln; const f32x4 g = gk[k], b = bk[k];
            const f32x4 z = y[k] * rstd * g + b;
            u32x2 o; o.x = cvt_pk_bf16(fast_silu(z[0]), fast_silu(z[1])); o.y = cvt_pk_bf16(fast_silu(z[2]), fast_silu(z[3]));
            *(GAS u32x2*)((char*)(CACT + (size_t)(rowA + t) * DCONV) + c * 2u) = o; }
    }
}
constexpr int CV_ROWS = 16 + CW - 1, CV_STAGE = CV_ROWS * DCONV * 2;
__device__ __forceinline__ void conv_stage(Frame& F, LAS unsigned char* S, int rowA, int pos0, size_t src_off = WS_A) {
    const bf16_t* A = WSP(bf16_t, src_off);
    unsigned ln = (unsigned)F.lane; asm volatile("" : "+v"(ln));
#pragma unroll 1
    for (int i = F.wave; i < CV_ROWS * 3; i += NWAVES) { const int row = i / 3, th = i - 3 * row, rel = row - (CW - 1);
        if (pos0 + rel >= 0) __builtin_amdgcn_global_load_lds((const unsigned*)((const char*)(A + (size_t)(rowA + rel) * DCONV) + th * 1024 + ln * 16u), (LAS unsigned*)(S + i * 1024), 16, 0, 0);
        else *(LAS u32x4*)(S + i * 1024 + ln * 16u) = (u32x4){0u, 0u, 0u, 0u}; }
}
constexpr int CV_TBL = 147456;
__device__ __forceinline__ void p2_conv_unit_prompt(Frame& F, int unit, int next_pm = -1, size_t src_off = WS_A, size_t dst_off = WS_CACT) {
    LAS unsigned char* S = F.lds;
    LAS float* WPT = (LAS float*)(F.lds + CV_TBL);
    LAS float* MR = WPT + 256;
    bf16_t* CACT = WSP(bf16_t, dst_off);
    unsigned ln = (unsigned)F.lane; asm volatile("" : "+v"(ln));
    const unsigned p = 192u * (unsigned)F.wave + 2u * ln, q = 192u * (unsigned)F.wave + 128u + ln;
    f32x2 wp[CW]; float wq[CW];
#pragma unroll
    for (int j = 0; j < CW; ++j) { wp[j] = ldg<f32x2>(F.in[14] + (size_t)j * DCONV, p * 4u); wq[j] = ldg<float>(F.in[14] + (size_t)j * DCONV, q * 4u); }
    const f32x2 bp = ldg<f32x2>(F.in[15], p * 4u), gp = ldg<f32x2>(F.in[16], p * 4u), hp = ldg<f32x2>(F.in[17], p * 4u);
    const float bq = ldg<float>(F.in[15], q * 4u), gq = ldg<float>(F.in[16], q * 4u), hq = ldg<float>(F.in[17], q * 4u);
    const int pos_u = (unit & 63) * 32;
    conv_stage(F, S, unit * 32, pos_u, src_off);
#pragma unroll 1
    for (int h = 0; h < 2; ++h) { const int rowA = unit * 32 + 16 * h;
        asm volatile("s_waitcnt vmcnt(0) lgkmcnt(0)" ::: "memory"); __syncthreads();
        f32x2 ap[16]; float aq[16];
#pragma unroll
        for (int t = 0; t < 16; ++t) { ap[t] = bp; aq[t] = bq; }
#pragma unroll
        for (int rg = 0; rg < CV_ROWS; rg += 8) {
            unsigned w2[8], w1[8];
#pragma unroll
            for (int i = 0; i < 8; ++i) if (rg + i < CV_ROWS) { w2[i] = *(const LAS unsigned*)(S + (rg + i) * (DCONV * 2) + p * 2u); w1[i] = *(const LAS unsigned short*)(S + (rg + i) * (DCONV * 2) + q * 2u); }
#pragma unroll
            for (int i = 0; i < 8; ++i) if (rg + i < CV_ROWS) { const int rr = rg + i; const f32x2 vp = (f32x2){bf_lo(w2[i]), bf_hi(w2[i])}; const float vq = bf_lo(w1[i]);
#pragma unroll
                for (int t = 0; t < 16; ++t) { const int j = rr - t; if (j >= 0 && j < CW) { ap[t] += wp[j] * vp; aq[t] += wq[j] * vq; } } }
            __builtin_amdgcn_sched_barrier(0); }
        LDS_WAIT(); __syncthreads();
        if (h == 0) conv_stage(F, S, rowA + 16, pos_u + 16, src_off);
        else if (next_pm >= 0) poolmix_stage(F, next_pm);
        float st[32];
#pragma unroll
        for (int t = 0; t < 16; ++t) { st[t] = (ap[t].x + ap[t].y) + aq[t]; st[16 + t] = (ap[t].x * ap[t].x + ap[t].y * ap[t].y) + aq[t] * aq[t]; }
        float tot = 0.f;
#pragma unroll
        for (int i = 0; i < 32; ++i) { const float w = wave_sum(st[i]); tot = (ln == (unsigned)i) ? w : tot; }
        if (ln < 32u) WPT[F.wave * 32 + (int)ln] = tot;
        LDS_WAIT(); __syncthreads();
        if (F.tid < 16) { float s1 = 0.f, s2 = 0.f;
#pragma unroll
            for (int w = 0; w < 8; ++w) { s1 += WPT[w * 32 + F.tid]; s2 += WPT[w * 32 + 16 + F.tid]; }
            const float mean = s1 * (1.0f / DCONV), var = fmaxf(s2 * (1.0f / DCONV) - mean * mean, 0.f);
            MR[2 * F.tid] = mean; MR[2 * F.tid + 1] = 1.0f / sqrtf(var + EPS); }
        LDS_WAIT(); __syncthreads();
#pragma unroll
        for (int t = 0; t < 16; ++t) { const f32x2 mr = *(const LAS f32x2*)(MR + 2 * t);
            const float z0 = (ap[t].x - mr.x) * mr.y * gp.x + hp.x, z1 = (ap[t].y - mr.x) * mr.y * gp.y + hp.y, z2 = (aq[t] - mr.x) * mr.y * gq + hq;
            char* orow = (char*)(CACT + (size_t)(rowA + t) * DCONV);
            *(GAS unsigned*)(orow + p * 2u) = cvt_pk_bf16(fast_silu(z0), fast_silu(z1));
            *(GAS unsigned short*)(orow + q * 2u) = (unsigned short)(cvt_pk_bf16(fast_silu(z2), 0.f) & 0xffffu); }
    }
    LDS_WAIT(); __syncthreads();
}
__device__ __forceinline__ void p2_conv_unit_sample(Frame& F, int bs) {
    LAS float* Y = (LAS float*)F.lds;
    unsigned p = 192u * (unsigned)F.wave + 2u * (unsigned)F.lane, q = 192u * (unsigned)F.wave + 128u + (unsigned)F.lane;
    asm volatile("" : "+v"(p), "+v"(q));
    f32x2 wp[CW]; float wq[CW];
#pragma unroll
    for (int j = 0; j < CW; ++j) { wp[j] = ldg<f32x2>(F.in[14] + (size_t)j * DCONV, p * 4u); wq[j] = ldg<float>(F.in[14] + (size_t)j * DCONV, q * 4u); }
    const f32x2 bp = ldg<f32x2>(F.in[15], p * 4u); const float bq = ldg<float>(F.in[15], q * 4u);
    const int rowA = MP + bs * DS;
    conv_block16<true, 1>(F, rowA, wp, wq, bp, bq, Y);
    LDS_WAIT(); __syncthreads();
    conv_norm16(F, rowA, Y, DS);
    LDS_WAIT(); __syncthreads();
}
__device__ __forceinline__ void stage_tile256(LAS unsigned char* T, const bf16_t* g, int pitch, int tid_) {
    unsigned tid = (unsigned)tid_; asm volatile("" : "+v"(tid));
    const unsigned r5 = tid >> 5, ch = tid & 31u, voff = r5 * (unsigned)pitch * 2u + ch * 16u, loff = r5 * 512u + ((ch ^ (r5 & 15u)) << 4);
    u32x4 v[16];
#pragma unroll
    for (int i = 0; i < 16; ++i) v[i] = ldg<u32x4>(g + (size_t)(16 * i) * pitch, voff);
#pragma unroll
    for (int i = 0; i < 16; ++i) *(LAS u32x4*)(T + loff + i * 8192) = v[i];
}
__device__ __forceinline__ void p2_attn_prompt_unit(Frame& F, int unit) {
    const int qb = unit & 15, h = (unit >> 4) & 3, b = unit >> 6;
    int ln_ = F.lane; asm volatile("" : "+v"(ln_));
    const int fr = ln_ & 15, g = ln_ >> 4;
    const int row = b * SEQ + qb * 128 + F.wave * 16 + fr;
    const bf16_t* Q = WSP(bf16_t, WS_Q); const bf16_t* KP = WSP(bf16_t, WS_KP); const bf16_t* VPT = WSP(bf16_t, WS_VPT); const bf16_t* SGC = WSP(bf16_t, WS_SGC); bf16_t* CAT = WSP(bf16_t, WS_CAT);
    LAS unsigned char* T = F.lds;
    stage_tile256(T, KP + (size_t)(b * NMEM) * DX + h * HD, DX, F.tid);
    bf16x8 qf[8];
#pragma unroll
    for (int ks = 0; ks < 8; ++ks) qf[ks] = *(const GAS bf16x8*)(Q + (size_t)row * DX + h * HD + 32 * ks + 8 * g);
    LDS_WAIT(); __syncthreads();
    f32x4 s[16];
    const int xt = g ^ fr;
#pragma unroll
    for (int nb = 0; nb < 16; ++nb) { s[nb] = (f32x4){0.f, 0.f, 0.f, 0.f}; bf16x8 kf[8];
#pragma unroll
        for (int ks = 0; ks < 8; ++ks) kf[ks] = *(const LAS bf16x8*)(T + (16 * nb + fr) * 512 + (((4 * ks) ^ xt) << 4));
#pragma unroll
        for (int ks = 0; ks < 8; ++ks) s[nb] = __builtin_amdgcn_mfma_f32_16x16x32_bf16(kf[ks], qf[ks], s[nb], 0, 0, 0); }
    float mx = -3.0e38f;
#pragma unroll
    for (int nb = 0; nb < 16; ++nb) mx = fmaxf(fmaxf(fmaxf(s[nb][0], s[nb][1]), fmaxf(s[nb][2], s[nb][3])), mx);
    mx = fmaxf(mx, __shfl_xor(mx, 16)); mx = fmaxf(mx, __shfl_xor(mx, 32));
    const float sc = 0.0625f * 1.44269504089f; float sum = 0.f;
#pragma unroll
    for (int nb = 0; nb < 16; ++nb)
#pragma unroll
        for (int r = 0; r < 4; ++r) { const float p = __builtin_amdgcn_exp2f((s[nb][r] - mx) * sc); s[nb][r] = p; sum += p; }
    sum += __shfl_xor(sum, 16); sum += __shfl_xor(sum, 32);
    const float inv = 1.0f / sum;
    bf16x8 pf[8];
#pragma unroll
    for (int i = 0; i < 8; ++i) { u32x4 w; w.x = cvt_pk_bf16(s[2 * i][0], s[2 * i][1]); w.y = cvt_pk_bf16(s[2 * i][2], s[2 * i][3]); w.z = cvt_pk_bf16(s[2 * i + 1][0], s[2 * i + 1][1]); w.w = cvt_pk_bf16(s[2 * i + 1][2], s[2 * i + 1][3]);
        pf[i] = __builtin_bit_cast(bf16x8, w); }
    u32x2 gts[16];
#pragma unroll
    for (int eb = 0; eb < 16; ++eb) gts[eb] = *(const GAS u32x2*)(SGC + (size_t)row * DX + h * HD + 16 * eb + 4 * g);
    __syncthreads();
    stage_tile256(T, VPT + (size_t)(h * HD) * DX + b * NMEM, DX, F.tid);
    LDS_WAIT(); __syncthreads();
#pragma unroll
    for (int eb = 0; eb < 16; ++eb) { f32x4 o = (f32x4){0.f, 0.f, 0.f, 0.f};
        u32x2 lo[8], hi[8];
#pragma unroll
        for (int i = 0; i < 8; ++i) { const int e = 16 * eb + fr;
            const LAS unsigned char* rp = T + e * 512 + 8 * (g & 1);
            lo[i] = *(const LAS u32x2*)(rp + (((4 * i + (g >> 1)) ^ fr) << 4)); hi[i] = *(const LAS u32x2*)(rp + (((4 * i + 2 + (g >> 1)) ^ fr) << 4)); }
#pragma unroll
        for (int i = 0; i < 8; ++i) { const u32x4 w = (u32x4){lo[i].x, lo[i].y, hi[i].x, hi[i].y};
            o = __builtin_amdgcn_mfma_f32_16x16x32_bf16(__builtin_bit_cast(bf16x8, w), pf[i], o, 0, 0, 0); }
        const u32x2 gt = gts[eb];
        u32x2 w; w.x = cvt_pk_bf16(o[0] * inv * bf_lo(gt.x), o[1] * inv * bf_hi(gt.x)); w.y = cvt_pk_bf16(o[2] * inv * bf_lo(gt.y), o[3] * inv * bf_hi(gt.y));
        *(GAS u32x2*)(CAT + (size_t)row * DM + 3072 + h * HD + 16 * eb + 4 * g) = w; }
    LDS_WAIT(); __syncthreads();
}
__device__ __forceinline__ void attn_sample_head_unit(Frame& F, int unit) {
    const int b = unit >> 2, head = unit & 3;
    unsigned ln = (unsigned)F.lane; asm volatile("" : "+v"(ln));
    const unsigned hk = ln >> 5, e0 = (ln & 31u) * 8u;
    const bf16_t* Q = WSP(bf16_t, WS_Q); const bf16_t* SGC = WSP(bf16_t, WS_SGC); bf16_t* CAT = WSP(bf16_t, WS_CAT);
    LAS float* SL = (LAS float*)F.lds;
    LAS float* OL = (LAS float*)(F.lds + 4096);
    float q[4][8];
#pragma unroll
    for (int t = 0; t < 4; ++t) { const u32x4 w = ldg<u32x4>(Q + (size_t)(MP + b * DS + t) * DX + head * HD, e0 * 2u);
        q[t][0] = bf_lo(w.x); q[t][1] = bf_hi(w.x); q[t][2] = bf_lo(w.y); q[t][3] = bf_hi(w.y); q[t][4] = bf_lo(w.z); q[t][5] = bf_hi(w.z); q[t][6] = bf_lo(w.w); q[t][7] = bf_hi(w.w); }
    const float* Kc = F.in[3] + (size_t)b * NMEM * DX + head * HD + (size_t)(32 * F.wave) * DX;
    const float* Vc = F.in[4] + (size_t)b * NMEM * DX + head * HD + (size_t)(32 * F.wave) * DX;
    const unsigned koff = hk * (DX * 4u) + e0 * 4u;
#pragma unroll 1
    for (int kb = 0; kb < 2; ++kb) {
        f32x4 ka[8], kc[8];
#pragma unroll
        for (int j = 0; j < 8; ++j) { const float* pp = Kc + (size_t)(16 * kb + 2 * j) * DX; ka[j] = ldg_nt<f32x4>(pp, koff); kc[j] = ldg_nt<f32x4>(pp, koff + 16u); }
#pragma unroll
        for (int j = 0; j < 8; ++j) { float d[4];
#pragma unroll
            for (int t = 0; t < 4; ++t) d[t] = (ka[j].x * q[t][0] + ka[j].y * q[t][1]) + (ka[j].z * q[t][2] + ka[j].w * q[t][3]) + (kc[j].x * q[t][4] + kc[j].y * q[t][5]) + (kc[j].z * q[t][6] + kc[j].w * q[t][7]);
#pragma unroll
            for (int t = 0; t < 4; ++t) {
#pragma unroll
                for (int o = 1; o < 32; o <<= 1) d[t] += __shfl_xor(d[t], o); }
            if ((ln & 31u) == 0u) *(LAS f32x4*)(SL + (32 * F.wave + 16 * kb + 2 * j + (int)hk) * 4) = (f32x4){d[0], d[1], d[2], d[3]}; } }
    LDS_WAIT(); __syncthreads();
    if (F.wave < 4) { const int st = F.wave; float v[4]; float mx = -3.0e38f;
#pragma unroll
        for (int i = 0; i < 4; ++i) { v[i] = SL[(ln + 64u * i) * 4 + st]; mx = fmaxf(mx, v[i]); }
#pragma unroll
        for (int o = 1; o < 64; o <<= 1) mx = fmaxf(mx, __shfl_xor(mx, o));
        float sum = 0.f;
#pragma unroll
        for (int i = 0; i < 4; ++i) { v[i] = __builtin_amdgcn_exp2f((v[i] - mx) * (0.0625f * 1.44269504089f)); sum += v[i]; }
        sum = wave_sum(sum); const float inv = 1.0f / sum;
#pragma unroll
        for (int i = 0; i < 4; ++i) SL[(ln + 64u * i) * 4 + st] = v[i] * inv; }
    LDS_WAIT(); __syncthreads();
    float o[4][8];
#pragma unroll
    for (int t = 0; t < 4; ++t)
#pragma unroll
        for (int e = 0; e < 8; ++e) o[t][e] = 0.f;
#pragma unroll 1
    for (int kb = 0; kb < 2; ++kb) {
        f32x4 va[8], vc[8];
#pragma unroll
        for (int j = 0; j < 8; ++j) { const float* pp = Vc + (size_t)(16 * kb + 2 * j) * DX; va[j] = ldg_nt<f32x4>(pp, koff); vc[j] = ldg_nt<f32x4>(pp, koff + 16u); }
#pragma unroll
        for (int j = 0; j < 8; ++j) { const f32x4 pr = *(const LAS f32x4*)(SL + (32 * F.wave + 16 * kb + 2 * j + (int)hk) * 4);
#pragma unroll
            for (int t = 0; t < 4; ++t) { o[t][0] += pr[t] * va[j].x; o[t][1] += pr[t] * va[j].y; o[t][2] += pr[t] * va[j].z; o[t][3] += pr[t] * va[j].w; o[t][4] += pr[t] * vc[j].x; o[t][5] += pr[t] * vc[j].y; o[t][6] += pr[t] * vc[j].z; o[t][7] += pr[t] * vc[j].w; } } }
#pragma unroll
    for (int t = 0; t < 4; ++t)
#pragma unroll
        for (int e = 0; e < 8; ++e) o[t][e] += __shfl_xor(o[t][e], 32);
    if (hk == 0u) {
#pragma unroll
        for (int t = 0; t < 4; ++t) { LAS float* pp = OL + (F.wave * 4 + t) * 256 + e0; *(LAS f32x4*)pp = (f32x4){o[t][0], o[t][1], o[t][2], o[t][3]}; *(LAS f32x4*)(pp + 4) = (f32x4){o[t][4], o[t][5], o[t][6], o[t][7]}; } }
    LDS_WAIT(); __syncthreads();
    if (F.tid < 256) { const int t = F.tid >> 6, e = (F.tid & 63) * 4;
        f32x4 a = (f32x4){0.f, 0.f, 0.f, 0.f};
#pragma unroll
        for (int w = 0; w < 8; ++w) a += *(const LAS f32x4*)(OL + (w * 4 + t) * 256 + e);
        const size_t row = (size_t)(MP + b * DS + t); const int col = head * HD + e;
        const u32x2 gt = *(const GAS u32x2*)(SGC + row * DX + col);
        u32x2 w; w.x = cvt_pk_bf16(a[0] * bf_lo(gt.x), a[1] * bf_hi(gt.x)); w.y = cvt_pk_bf16(a[2] * bf_lo(gt.y), a[3] * bf_hi(gt.y));
        *(GAS u32x2*)(CAT + row * DM + 3072 + col) = w; }
    LDS_WAIT(); __syncthreads();
}

constexpr int NAS_UNITS = DB * NH, NAS_FREE_FROM = G1_ALL - 5 * 256;
constexpr int P2_NAS = 256, P2_NAP = 256, P2_NCV = 256 + MS / 16, P2_NPL = MT / 32;
__device__ __forceinline__ void p2_mixers(LAS unsigned char* lds) {
    if ((int)gridDim.x != 256) { Frame F = make_frame(lds); for (int u = F.vcu; u < NAS_UNITS; u += F.G) attn_sample_head_unit(F, u); }
    { Frame F = make_frame(lds); for (int u = F.vcu; u < P2_NAP; u += F.G) p2_attn_prompt_unit(F, u); }
    { Frame F = make_frame(lds); for (int bs = (F.vcu + F.G - 64) % F.G; bs < DB; bs += F.G) p2_conv_unit_sample(F, bs); }
    { Frame F = make_frame(lds); const bool one = (int)gridDim.x == 256;
      for (int u = F.vcu; u < 256; u += F.G) p2_conv_unit_prompt(F, u, one ? u : -1); }
    { Frame F = make_frame(lds); const bool fused = (int)gridDim.x == 256;
      for (int u = F.vcu; u < 256; u += F.G) p2_poolmix_unit(F, u, fused); }
    { Frame F = make_frame(lds);
      for (int sidx = ((F.vcu + F.G - 192) % F.G) * NWAVES + F.wave; sidx < 16 * 24; sidx += F.G * NWAVES) p2_pool_sample_task(F, sidx); }
    { Frame F = make_frame(lds); p2_states(F); if ((int)gridDim.x != 256) states_copy_rows(F, F.vcu * NWAVES + F.wave, F.G * NWAVES); }
}

struct Sched3pw { int G, c; const char *CACT, *WPW;
    __device__ __forceinline__ bool next(int i, Unit& u) const { const int L = i * G + c; if (L >= G1_NM * 6) return false;
        int pm, pn; pg8::tile_order(L, G1_NM, 6, pm, pn); u.pm = pm; u.pn = pn; u.kind = 0; u.nt = DCONV / 64; u.A = CACT + (size_t)pm * 256 * DCONV * 2; u.B = WPW + (size_t)pn * 256 * DCONV * 2; return true; } };
struct Sched3pl { int G, c; const char *POOLED, *WPOOL;
    __device__ __forceinline__ bool next(int i, Unit& u) const { const int L = i * G + c; if (L >= 2 * 8) return false;
        const int pm = MP / 256 + (L >> 3), pn = L & 7; u.pm = pm; u.pn = pn; u.kind = 1; u.nt = PGRP / 64; const int g = pn >> 1;
        u.A = POOLED + (size_t)pm * 256 * DPOOL * 2 + (size_t)g * PGRP * 2; u.B = WPOOL + (size_t)pn * 256 * PGRP * 2; return true; } };
template <int KIND> struct Epi3 {
    const bf16_t *SGA, *SGB; const float* pscale; bf16_t* CAT;
    __device__ __forceinline__ void operator()(const f32x4 (&acc)[2][2][4][2], const Unit& u, int wr, int wc, int fr, int fq) const {
        const int row0 = u.pm * 256 + wr * 64 + fr, cl = wc * 32 + 8 * fq;
        if constexpr (KIND == 0) {
            const int col0 = u.pn * 256 + cl;
            u32x4 gts[2][4][2];
#pragma unroll
            for (int ai = 0; ai < 2; ++ai)
#pragma unroll
                for (int m = 0; m < 4; ++m)
#pragma unroll
                    for (int bj = 0; bj < 2; ++bj) gts[ai][m][bj] = *(const u32x4*)(SGB + (size_t)(row0 + ai * 128 + m * 16) * DCONV + col0 + bj * 128);
#pragma unroll
            for (int ai = 0; ai < 2; ++ai)
#pragma unroll
                for (int m = 0; m < 4; ++m)
#pragma unroll
                    for (int bj = 0; bj < 2; ++bj) { const size_t r = (size_t)(row0 + ai * 128 + m * 16); const int c = col0 + bj * 128;
                        const u32x4 gt = gts[ai][m][bj]; const f32x4 v0 = acc[ai][bj][m][0], v1 = acc[ai][bj][m][1];
                        u32x4 w; w.x = cvt_pk_bf16(v0[0] * bf_lo(gt.x), v0[1] * bf_hi(gt.x)); w.y = cvt_pk_bf16(v0[2] * bf_lo(gt.y), v0[3] * bf_hi(gt.y));
                        w.z = cvt_pk_bf16(v1[0] * bf_lo(gt.z), v1[1] * bf_hi(gt.z)); w.w = cvt_pk_bf16(v1[2] * bf_lo(gt.w), v1[3] * bf_hi(gt.w));
                        *(u32x4*)(CAT + r * DM + DPOOL + c) = w; }
        } else {
            const int g = u.pn >> 1, half = u.pn & 1;
#pragma unroll
            for (int bj = 0; bj < 2; ++bj) { const int cg = half * 256 + bj * 128 + cl;
                if (!(half == 1 && bj == 1)) { const int c = g * PGRP + cg;
                    const f32x4 s0 = *(const f32x4*)(pscale + c), s1 = *(const f32x4*)(pscale + c + 4);
                    u32x4 gts[2][4];
#pragma unroll
                    for (int ai = 0; ai < 2; ++ai)
#pragma unroll
                        for (int m = 0; m < 4; ++m) gts[ai][m] = *(const u32x4*)(SGA + (size_t)(row0 + ai * 128 + m * 16) * DPOOL + c);
#pragma unroll
                    for (int ai = 0; ai < 2; ++ai)
#pragma unroll
                        for (int m = 0; m < 4; ++m) { const size_t r = (size_t)(row0 + ai * 128 + m * 16);
                            const u32x4 gt = gts[ai][m]; const f32x4 v0 = acc[ai][bj][m][0] * s0, v1 = acc[ai][bj][m][1] * s1;
                            u32x4 w; w.x = cvt_pk_bf16(v0[0] * bf_lo(gt.x), v0[1] * bf_hi(gt.x)); w.y = cvt_pk_bf16(v0[2] * bf_lo(gt.y), v0[3] * bf_hi(gt.y));
                            w.z = cvt_pk_bf16(v1[0] * bf_lo(gt.z), v1[1] * bf_hi(gt.z)); w.w = cvt_pk_bf16(v1[2] * bf_lo(gt.w), v1[3] * bf_hi(gt.w));
                            *(u32x4*)(CAT + r * DM + c) = w; } } }
        }
    }
};

struct Sched4 { int G, c; const char *CAT, *WOUT;
    __device__ __forceinline__ bool next(int i, Unit& u) const {
        constexpr int NPT = (MP / 256) * 16;
        const int L = i * G + c;
        if (L < NPT) { int pm, pn; pg8::tile_order(L, MP / 256, 16, pm, pn); u.pm = pm; u.pn = pn; u.kind = 0; u.nt = DM / 64; u.A = CAT + (size_t)pm * TSTEP4K; u.B = WOUT + (size_t)pn * TSTEP4K; return true; }
        const int q = L - NPT; if (q >= 256) return false;
        const int r = q >> 3, p = q & 7, pm = MP / 256 + (r >> 4), pn = r & 15;
        u.pm = pm; u.pn = pn; u.kind = 1 + p; u.nt = 8; u.A = CAT + (size_t)pm * TSTEP4K + (size_t)p * 1024; u.B = WOUT + (size_t)pn * TSTEP4K + (size_t)p * 1024; return true;
    }
};
__device__ __forceinline__ unsigned pk_f16(float a, float b) { return (unsigned)__builtin_bit_cast(unsigned short, (_Float16)a) | ((unsigned)__builtin_bit_cast(unsigned short, (_Float16)b) << 16); }
__device__ __forceinline__ float h_lo(unsigned w) { return (float)__builtin_bit_cast(_Float16, (unsigned short)(w & 0xffffu)); }
__device__ __forceinline__ float h_hi(unsigned w) { return (float)__builtin_bit_cast(_Float16, (unsigned short)(w >> 16)); }
struct Epi4 {
    unsigned short* y; unsigned short* part;
    __device__ __forceinline__ void operator()(const f32x4 (&acc)[2][2][4][2], const Unit& u, int wr, int wc, int fr, int fq) const {
        const int row0 = u.pm * 256 + wr * 64 + fr, col0 = u.pn * 256 + wc * 32 + 8 * fq;
        if (u.kind == 0) {
            unsigned short* yb = y + (size_t)row0 * DM + col0;
#pragma unroll
            for (int ai = 0; ai < 2; ++ai)
#pragma unroll
                for (int m = 0; m < 4; ++m) { unsigned short* yp = yb + (size_t)(ai * 128 + m * 16) * DM;
                    const f32x4 y0 = acc[ai][0][m][0], y1 = acc[ai][0][m][1], y2 = acc[ai][1][m][0], y3 = acc[ai][1][m][1];
                    *(u32x4*)yp = (u32x4){pk_f16(y0[0], y0[1]), pk_f16(y0[2], y0[3]), pk_f16(y1[0], y1[1]), pk_f16(y1[2], y1[3])}; *(u32x4*)(yp + 128) = (u32x4){pk_f16(y2[0], y2[1]), pk_f16(y2[2], y2[3]), pk_f16(y3[0], y3[1]), pk_f16(y3[2], y3[3])}; }
        } else {
            unsigned short* pb = part + ((size_t)(u.kind - 1) * MS + (size_t)(row0 - MP)) * DM + col0;
#pragma unroll
            for (int ai = 0; ai < 2; ++ai)
#pragma unroll
                for (int m = 0; m < 4; ++m) { unsigned short* pp = pb + (size_t)(ai * 128 + m * 16) * DM;
                    const f32x4 y0 = acc[ai][0][m][0], y1 = acc[ai][0][m][1], y2 = acc[ai][1][m][0], y3 = acc[ai][1][m][1];
                    *(u32x4*)pp = (u32x4){pk_f16(y0[0], y0[1]), pk_f16(y0[2], y0[3]), pk_f16(y1[0], y1[1]), pk_f16(y1[2], y1[3])}; *(u32x4*)(pp + 128) = (u32x4){pk_f16(y2[0], y2[1]), pk_f16(y2[2], y2[3]), pk_f16(y3[0], y3[1]), pk_f16(y3[2], y3[3])}; }
        }
    }
};

template <bool SAMPLE> __device__ __forceinline__ void p5_row(Frame& F, int m, float* dst) {
    f32x4 v[16];
    const GAS f32x4* x8 = (const GAS f32x4*)((SAMPLE ? F.in[2] + (size_t)(m - MP) * DM : F.in[0] + (size_t)m * DM)) + 2 * F.lane;
    if (!SAMPLE) {
        const GAS u32x4* yr = (const GAS u32x4*)(F.ws + WS_YH + (size_t)m * DM * 2) + F.lane;
        u32x4 w[8];
#pragma unroll
        for (int j = 0; j < 8; ++j) { w[j] = yr[64 * j]; v[2 * j] = x8[128 * j]; v[2 * j + 1] = x8[128 * j + 1]; }
#pragma unroll
        for (int j = 0; j < 8; ++j) { v[2 * j] += (f32x4){h_lo(w[j].x), h_hi(w[j].x), h_lo(w[j].y), h_hi(w[j].y)}; v[2 * j + 1] += (f32x4){h_lo(w[j].z), h_hi(w[j].z), h_lo(w[j].w), h_hi(w[j].w)}; }
    } else {
#pragma unroll
        for (int j = 0; j < 8; ++j) { v[2 * j] = x8[128 * j]; v[2 * j + 1] = x8[128 * j + 1]; }
#pragma unroll 2
        for (int p = 0; p < 8; ++p) { const GAS u32x4* pr = (const GAS u32x4*)(F.ws + WS_SLAB + ((size_t)p * MS + (m - MP)) * DM * 2) + F.lane;
            u32x4 w[8];
#pragma unroll
            for (int j = 0; j < 8; ++j) w[j] = pr[64 * j];
#pragma unroll
            for (int j = 0; j < 8; ++j) { v[2 * j] += (f32x4){h_lo(w[j].x), h_hi(w[j].x), h_lo(w[j].y), h_hi(w[j].y)}; v[2 * j + 1] += (f32x4){h_lo(w[j].z), h_hi(w[j].z), h_lo(w[j].w), h_hi(w[j].w)}; } }
    }
    float s = 0.f;
#pragma unroll
    for (int j = 0; j < 16; ++j) s += (v[j].x * v[j].x + v[j].y * v[j].y) + (v[j].z * v[j].z + v[j].w * v[j].w);
    const float rstd = 1.0f / sqrtf(wave_sum(s) * (1.0f / DM) + EPS);
    const GAS f32x4* g8 = (const GAS f32x4*)F.in[20] + 2 * F.lane; GAS f32x4* y8 = (GAS f32x4*)(dst + (size_t)m * DM) + 2 * F.lane;
    f32x4 gv[16];
#pragma unroll
    for (int j = 0; j < 8; ++j) { gv[2 * j] = g8[128 * j]; gv[2 * j + 1] = g8[128 * j + 1]; }
#pragma unroll
    for (int j = 0; j < 8; ++j) { y8[128 * j] = v[2 * j] * rstd * gv[2 * j]; y8[128 * j + 1] = v[2 * j + 1] * rstd * gv[2 * j + 1]; }
}
__device__ __forceinline__ void p5_final_norm(Frame& F, float* dst) {
    const int gw = F.vcu * NWAVES + F.wave, NGW = F.G * NWAVES;
    for (int r = F.wave * F.G + F.vcu; r < MS; r += NGW) p5_row<true>(F, MP + r, dst);
    for (int m = gw; m < MP; m += NGW) p5_row<false>(F, m, dst);
}

__global__ void __launch_bounds__(NTHR, 2) hybrid_fwd(Args args) {
    extern __shared__ __attribute__((aligned(16))) unsigned char lds_raw[];
    LAS unsigned char* lds = (LAS unsigned char*)lds_raw;
    volatile LAS unsigned* MISC = (volatile LAS unsigned*)(lds + LDSCTL_OFF);
    if (threadIdx.x < 64) MISC[threadIdx.x] = 0u;
    __syncthreads();
    XcdBarrier bar = xcd_barrier_post((unsigned*)(args.ws + WS_CTL) + CW_BAR, MISC + 8);

    { Frame F = make_frame(lds); p0_prologue(F, (int)gridDim.x != 256); }
    xcd_barrier(bar);
    { Frame F = make_frame(lds);
      Sched1 S{F.G, (int)blockIdx.x, (const char*)(F.ws + WS_H), (const char*)(F.ws + WS_HM), (const char*)(F.ws + WS_WIN), (const char*)(F.ws + WS_WKV)};
      Epi1 E{WSP(bf16_t, WS_U), WSP(bf16_t, WS_SGA), WSP(bf16_t, WS_A), WSP(bf16_t, WS_SGB), WSP(bf16_t, WS_Q), WSP(bf16_t, WS_SGC), WSP(bf16_t, WS_KP), WSP(bf16_t, WS_VPT), F.out + O_MK, F.out + O_MV, (unsigned*)(F.ws + WS_CTL) + CW_QREADY};
      pg8::gemm_phase<Epi1, Sched1, true, true>(F.lds, DM, DM, S, E); }
    if ((int)blockIdx.x >= NAS_FREE_FROM && (int)gridDim.x == 256) {
        Frame F = make_frame(lds);
        if (F.tid < 64) { unsigned* fl = (unsigned*)(F.ws + WS_CTL) + CW_QREADY; unsigned sp = 0;
            while (__hip_atomic_load(fl, __ATOMIC_RELAXED, __HIP_MEMORY_SCOPE_AGENT) < (unsigned)G1_SPECIAL) { __builtin_amdgcn_s_sleep(4); if (++sp > (1u << 22)) break; }
            __builtin_amdgcn_fence(__ATOMIC_ACQUIRE, "agent"); }
        asm volatile("s_waitcnt vmcnt(0)" ::: "memory"); __syncthreads();
        for (int u = (int)blockIdx.x - NAS_FREE_FROM; u < NAS_UNITS; u += 256 - NAS_FREE_FROM) attn_sample_head_unit(F, u);
    }
    {
        constexpr int NFREE = 256 - NAS_FREE_FROM, N3 = NAS_UNITS - 2 * NFREE, NLATE = NFREE - N3;
        const int idx = (int)blockIdx.x - NAS_FREE_FROM - N3;
        if (idx >= 0 && (int)gridDim.x == 256) { Frame F = make_frame(lds);
            p0_items(F, NITEMS_EARLY, NITEMS, idx * NWAVES + F.wave, NLATE * NWAVES);
            p0_pool_pad(F, idx * NTHR + F.tid, NLATE * NTHR); p0_pool_frag(F, idx * NTHR + F.tid, NLATE * NTHR); }
    }
    if ((int)blockIdx.x >= NAS_FREE_FROM && (int)gridDim.x == 256) {
        Frame F = make_frame(lds); states_copy_rows(F, ((int)blockIdx.x - NAS_FREE_FROM) * NWAVES + F.wave, (256 - NAS_FREE_FROM) * NWAVES); }
    xcd_barrier(bar);
    p2_mixers(lds);
    xcd_barrier(bar);
    { Frame F = make_frame(lds);
      Epi3<0> E{WSP(bf16_t, WS_SGA), WSP(bf16_t, WS_SGB), F.in[13], WSP(bf16_t, WS_CAT)};
      Sched3pw Sw{F.G, (int)blockIdx.x, (const char*)(F.ws + WS_CACT), (const char*)(F.ws + WS_WPW)};
      pg8::gemm_phase<Epi3<0>, Sched3pw, true, true>(F.lds, DCONV, DCONV, Sw, E); }
    { Frame F = make_frame(lds);
      Epi3<1> E{WSP(bf16_t, WS_SGA), WSP(bf16_t, WS_SGB), F.in[13], WSP(bf16_t, WS_CAT)};
      Sched3pl Sp{F.G, (int)((blockIdx.x + 52) % F.G), (const char*)(F.ws + WS_POOLED), (const char*)(F.ws + WS_WPOOL)};
      pg8::gemm_phase<Epi3<1>, Sched3pl, true, true>(F.lds, DPOOL, PGRP, Sp, E); }
    xcd_barrier(bar);
    { Frame F = make_frame(lds);
      Sched4 S{F.G, (int)blockIdx.x, (const char*)(F.ws + WS_CAT), (const char*)(F.ws + WS_WOUT)};
      Epi4 E{(unsigned short*)(F.ws + WS_YH), (unsigned short*)(F.ws + WS_SLAB)};
      pg8::gemm_phase<Epi4, Sched4, true, true>(F.lds, DM, DM, S, E); }
    xcd_barrier(bar);
    { Frame F = make_frame(lds); p5_final_norm(F, F.out + O_Y); }
}

extern "C" void kernel_launch(void* const* d_in, const int* in_sizes, int n_in, void* d_out, int out_size, void* d_ws, size_t ws_size, hipStream_t stream) {
    static int grid = 0;
    if (grid == 0) {
        if (n_in != 21 || (size_t)out_size != O_END || ws_size < WS_END) { fprintf(stderr, "kernel_launch: unexpected shapes: n_in %d out %d ws %zu (need %zu)\n", n_in, out_size, ws_size, (size_t)WS_END); grid = -1; return; }
        int dev = 0, cus = 0, per_cu = 0;
        if (hipGetDevice(&dev) != hipSuccess || hipDeviceGetAttribute(&cus, hipDeviceAttributeMultiprocessorCount, dev) != hipSuccess) { grid = -1; return; }
        if (hipFuncSetAttribute((const void*)hybrid_fwd, hipFuncAttributeMaxDynamicSharedMemorySize, LDS_BYTES) != hipSuccess) { fprintf(stderr, "kernel_launch: hipFuncSetAttribute failed\n"); grid = -1; return; }
        if (hipOccupancyMaxActiveBlocksPerMultiprocessor(&per_cu, (const void*)hybrid_fwd, NTHR, LDS_BYTES) != hipSuccess || per_cu < 1) { fprintf(stderr, "kernel_launch: occupancy query reports %d blocks per CU\n", per_cu); }
        (void)hipGetLastError();
        grid = cus;
    }
    if (grid < 0) return;
    unsigned char* wsb = (unsigned char*)d_ws + ((ws_size - WS_END) & ~(size_t)(2 * MiB - 1));
    if (hipMemsetAsync((char*)wsb + WS_CTL, 0, CTL_ZERO_BYTES, stream) != hipSuccess) { fprintf(stderr, "kernel_launch: memset failed\n"); return; }
    Args a{};
    for (int i = 0; i < 21; ++i) a.in[i] = (const float*)d_in[i];
    a.out = (float*)d_out; a.ws = wsb;
    hipLaunchKernelGGL(hybrid_fwd, dim3(grid), dim3(NTHR), LDS_BYTES, stream, a);
}
```

```cpp
#include <hip/hip_runtime.h>
#include <cstdio>
#include <cstdint>

#define LAS __attribute__((address_space(3)))
#define GAS __attribute__((address_space(1)))
typedef unsigned short bf16_t;
typedef short bf16x8 __attribute__((ext_vector_type(8)));
typedef float f32x4 __attribute__((ext_vector_type(4)));
typedef float f32x2 __attribute__((ext_vector_type(2)));
typedef unsigned u32x4 __attribute__((ext_vector_type(4)));
typedef unsigned u32x2 __attribute__((ext_vector_type(2)));
typedef GAS unsigned gu32;

constexpr int DM = 4096, NB = 4, SEQ = 2048, DB = 128, DS = 4, NMEM = 256;
constexpr int DPOOL = 1536, DCONV = 1536, DX = 1024, NH = 4, HD = 256, PGRP = 384, DIN = 9728;
constexpr int MP = NB * SEQ, MS = DB * DS, MT = MP + MS, MM = NB * NMEM;
constexpr int PSTATE = 15, CSTATE = 30, CW = 31;
constexpr float EPS = 1e-6f;

constexpr size_t O_Y = 0;
constexpr size_t O_MK = (size_t)MT * DM;
constexpr size_t O_MV = O_MK + (size_t)MM * DX;
constexpr size_t O_PSP = O_MV + (size_t)MM * DX;
constexpr size_t O_CSP = O_PSP + (size_t)NB * PSTATE * DPOOL;
constexpr size_t O_PSS = O_CSP + (size_t)NB * CSTATE * DCONV;
constexpr size_t O_CSS = O_PSS + (size_t)DB * PSTATE * DPOOL;
constexpr size_t O_END = O_CSS + (size_t)DB * CSTATE * DCONV;

constexpr size_t MiB = 1u << 20;
constexpr size_t WS_CTL = 0, CTL_BYTES = 1 * MiB;
constexpr size_t WS_WOUT = 1 * MiB;
constexpr size_t WS_WPW = WS_WOUT + 32 * MiB;
constexpr size_t WS_WPOOL = WS_WPW + 5 * MiB;
constexpr size_t WS_WPOOLF = WS_WPOOL + 2 * MiB;
constexpr size_t WS_U = WS_WPOOLF + 2 * MiB;
constexpr size_t WS_SGA = WS_U + 26 * MiB;
constexpr size_t WS_A = WS_SGA + 26 * MiB;
constexpr size_t WS_SGB = WS_A + 26 * MiB;
constexpr size_t WS_Q = WS_SGB + 26 * MiB;
constexpr size_t WS_SGC = WS_Q + 17 * MiB;
constexpr size_t WS_KP = WS_SGC + 17 * MiB;
constexpr size_t WS_VPT = WS_KP + 2 * MiB;
constexpr size_t WS_POOLED = WS_VPT + 2 * MiB;
constexpr size_t WS_CACT = WS_POOLED + 26 * MiB;
constexpr size_t WS_CAT = WS_CACT + 26 * MiB;
constexpr size_t WS_SLAB = WS_CAT + 68 * MiB;
constexpr size_t WS_ROWSS = WS_SLAB + 64 * MiB;
constexpr size_t WS_YH = WS_ROWSS + 2 * MiB;
constexpr size_t WS_HM = WS_YH + 64 * MiB;
constexpr size_t WS_H = WS_HM + 8 * MiB;
constexpr size_t WS_WKV = WS_H + 68 * MiB;
constexpr size_t WS_WIN = WS_WKV + 16 * MiB;
constexpr size_t WS_END = WS_WIN + 76 * MiB;
constexpr int CW_BAR = 4096;
constexpr int CW_QREADY = 8192;
constexpr size_t CTL_ZERO_BYTES = 40 * 1024;
static_assert((CW_QREADY + 64) * 4 <= (int)CTL_ZERO_BYTES && (CW_BAR + 3456 + 64) * 4 <= (int)CTL_ZERO_BYTES, "ctl");

constexpr int RING_BYTES = 131072;
constexpr int LDS_BYTES = 163840;
constexpr int LDSCTL_OFF = LDS_BYTES - 1024;
constexpr int NWAVES = 8, NTHR = 512;

#define RLX_AGENT __ATOMIC_RELAXED, __HIP_MEMORY_SCOPE_AGENT
#define LDS_WAIT() asm volatile("s_waitcnt lgkmcnt(0)" ::: "memory")
#define VM_WAIT() asm volatile("s_waitcnt vmcnt(0)" ::: "memory")

__device__ __forceinline__ unsigned cvt_pk_bf16(float lo, float hi) { unsigned r; asm volatile("v_cvt_pk_bf16_f32 %0, %1, %2" : "=v"(r) : "v"(lo), "v"(hi)); return r; }
__device__ __forceinline__ float bf_lo(unsigned w) { return __uint_as_float(w << 16); }
__device__ __forceinline__ float bf_hi(unsigned w) { return __uint_as_float(w & 0xffff0000u); }
__device__ __forceinline__ float fast_sigmoid(float x) { return __builtin_amdgcn_rcpf(1.0f + __builtin_amdgcn_exp2f(-1.44269504089f * x)); }
__device__ __forceinline__ float fast_silu(float x) { return x * fast_sigmoid(x); }
__device__ __forceinline__ float wave_reduce32(float (&v)[32], int lane) {
#pragma unroll
    for (int s = 0; s < 5; ++s) { const int half = 16 >> s; const bool up = (lane >> s) & 1;
#pragma unroll
        for (int i = 0; i < half; ++i) { const float keep = up ? v[i + half] : v[i], send = up ? v[i] : v[i + half]; v[i] = keep + __shfl_xor(send, 1 << s); } }
    return v[0] + __shfl_xor(v[0], 32);
}
template <class T> __device__ __forceinline__ T ldg_nt(const void* ubase, unsigned boff) { return __builtin_nontemporal_load((const GAS T*)((const char*)ubase + boff)); }
template <class T> __device__ __forceinline__ T ldg(const void* ubase, unsigned boff) { return *(const GAS T*)((const char*)ubase + boff); }
template <int CTRL, int RM> __device__ __forceinline__ float dppf(float v) { return __builtin_bit_cast(float, __builtin_amdgcn_update_dpp(0, __builtin_bit_cast(int, v), CTRL, RM, 0xF, false)); }
__device__ __forceinline__ float row_sum_dpp(float v) {
    v += dppf<0xB1, 0xF>(v); v += dppf<0x4E, 0xF>(v); v += dppf<0x141, 0xF>(v); v += dppf<0x140, 0xF>(v); return v; }
__device__ __forceinline__ float half_sum_dpp(float v) {
    v = row_sum_dpp(v); v += dppf<0x142, 0xA>(v); return v; }
__device__ __forceinline__ float wave_sum(float v) {
    v = half_sum_dpp(v); v += dppf<0x143, 0xC>(v);
    return __builtin_bit_cast(float, __builtin_amdgcn_readlane(__builtin_bit_cast(int, v), 63)); }

__device__ __forceinline__ int fresh_tid() { int t = threadIdx.x; asm volatile("" : "+v"(t)); return t; }

#define XB_TMO      128
#define XB_XCNT(j)  (256  + 64 * (j))
#define XB_XSUB(j)  (1280 + 64 * (j))
#define XB_XGEN(j)  (2304 + 64 * (j))
#define XB_TOP      3328
#define XB_TOPGEN   3392
#define XCD_BAR_WORDS 3456
#define XB_SPIN_CAP (1u << 18)
__device__ __forceinline__ unsigned xb_ld(unsigned* p)              { return __hip_atomic_load(p, __ATOMIC_RELAXED, __HIP_MEMORY_SCOPE_AGENT); }
__device__ __forceinline__ unsigned xb_add(unsigned* p, unsigned v) { return __hip_atomic_fetch_add(p, v, __ATOMIC_RELAXED, __HIP_MEMORY_SCOPE_AGENT); }
__device__ __forceinline__ unsigned xb_xcc_id() { return (unsigned)__builtin_amdgcn_s_getreg((3 << 11) | 20) & 0xFu; }
#define XB_SPIN(cond, bar) do { unsigned _sp = 0; while (cond) { __builtin_amdgcn_s_sleep(1); \
    if ((++_sp & 255u) == 0u) { if (xb_ld(&(bar)[XB_TMO])) break; if (_sp > XB_SPIN_CAP) { atomicAdd(&(bar)[XB_TMO], 1u); break; } } } } while (0)
struct XcdBarrier { unsigned* bar; unsigned x; volatile LAS unsigned* st; };
__device__ __forceinline__ XcdBarrier xcd_barrier_post(unsigned* bar, volatile LAS unsigned* st) {
    XcdBarrier b; b.bar = bar; b.x = xb_xcc_id(); b.st = st;
    if (threadIdx.x == 0) (void)xb_add(&bar[XB_XCNT(b.x)], 1u);
    return b;
}
__device__ __forceinline__ void xcd_barrier_complete(unsigned* bar, unsigned x, unsigned& nloc, unsigned& nx) {
    const unsigned G = gridDim.x * gridDim.y * gridDim.z;
    unsigned sum, cnt, mine, sp = 0u;
    for (;;) {
        sum = 0u; cnt = 0u; mine = 0u;
#pragma unroll
        for (unsigned j = 0; j < 16; ++j) { const unsigned c = xb_ld(&bar[XB_XCNT(j)]); sum += c; cnt += (c > 0u) ? 1u : 0u; mine = (j == x) ? c : mine; }
        if (sum == G) break;
        __builtin_amdgcn_s_sleep(1);
        if ((++sp & 255u) == 0u) { if (xb_ld(&bar[XB_TMO])) break; if (sp > XB_SPIN_CAP) { atomicAdd(&bar[XB_TMO], 1u); break; } }
    }
    nloc = mine > 0u ? mine : 1u; nx = cnt > 0u ? cnt : 1u;
}
__device__ __forceinline__ void xcd_barrier(const XcdBarrier& b) {
    asm volatile("s_waitcnt vmcnt(0)" ::: "memory");
    __syncthreads();
    if (threadIdx.x == 0) {
        unsigned* bar = b.bar;
        __builtin_amdgcn_s_waitcnt(0);
        unsigned nloc = b.st[0], nx = b.st[1];
        if (nloc == 0u) { xcd_barrier_complete(bar, b.x, nloc, nx); b.st[0] = nloc; b.st[1] = nx; }
        const unsigned old = xb_add(&bar[XB_XSUB(b.x)], 1u);
        const unsigned gen = old / nloc;
        if (old + 1u == (gen + 1u) * nloc) {
            __builtin_amdgcn_fence(__ATOMIC_RELEASE, "agent");
            asm volatile("s_waitcnt vmcnt(0)" ::: "memory");
            const unsigned og = xb_add(&bar[XB_TOP], 1u);
            const unsigned tg = og / nx;
            if (og + 1u == (tg + 1u) * nx) xb_add(&bar[XB_TOPGEN], 1u);
            else XB_SPIN(xb_ld(&bar[XB_TOPGEN]) == tg, bar);
            __builtin_amdgcn_fence(__ATOMIC_ACQUIRE, "agent");
            asm volatile("s_waitcnt vmcnt(0)" ::: "memory");
        } else {
            XB_SPIN(xb_ld(&bar[XB_TOPGEN]) == gen, bar);
            __builtin_amdgcn_fence(__ATOMIC_ACQUIRE, "agent");
            asm volatile("s_waitcnt vmcnt(0)" ::: "memory");
        }
    }
    __syncthreads();
}

struct XbState { unsigned gen, tg; bool lastx, lastt; };
__device__ __forceinline__ XbState xcd_barrier_arrive(const XcdBarrier& b) {
    asm volatile("s_waitcnt vmcnt(0)" ::: "memory");
    __syncthreads();
    unsigned* bar = b.bar;
    XbState st; st.gen = 0u; st.tg = 0u; st.lastx = false; st.lastt = false;
    if (threadIdx.x == 0) {
        __builtin_amdgcn_s_waitcnt(0);
        unsigned nloc = b.st[0], nx = b.st[1];
        if (nloc == 0u) { xcd_barrier_complete(bar, b.x, nloc, nx); b.st[0] = nloc; b.st[1] = nx; }
        const unsigned old = xb_add(&bar[XB_XSUB(b.x)], 1u);
        st.gen = old / nloc; st.lastx = (old + 1u == (st.gen + 1u) * nloc);
        if (st.lastx) {
            __builtin_amdgcn_fence(__ATOMIC_RELEASE, "agent");
            asm volatile("s_waitcnt vmcnt(0)" ::: "memory");
            const unsigned og = xb_add(&bar[XB_TOP], 1u);
            st.tg = og / nx; st.lastt = (og + 1u == (st.tg + 1u) * nx);
            if (st.lastt) xb_add(&bar[XB_TOPGEN], 1u);
        }
    }
    return st;
}
__device__ __forceinline__ void xcd_barrier_wait(const XcdBarrier& b, const XbState& st) {
    unsigned* bar = b.bar;
    if (threadIdx.x == 0) {
        if (st.lastx) {
            if (!st.lastt) XB_SPIN(xb_ld(&bar[XB_TOPGEN]) == st.tg, bar);
            __builtin_amdgcn_fence(__ATOMIC_ACQUIRE, "agent");
            asm volatile("s_waitcnt vmcnt(0)" ::: "memory");
        } else {
            XB_SPIN(xb_ld(&bar[XB_TOPGEN]) == st.gen, bar);
            __builtin_amdgcn_fence(__ATOMIC_ACQUIRE, "agent");
            asm volatile("s_waitcnt vmcnt(0)" ::: "memory");
        }
    }
    __syncthreads();
}

namespace pg8 {
constexpr int BM = 256, BK = 64, HALF = 128, HTB = HALF * BK * 2, STAGE_BYTES = 8 * HTB, NXCD = 8, WGM = 8;
__host__ __device__ __forceinline__ int lds_byte(int r, int c) { const int st = (r >> 4) * 2 + (c >> 5), rr = r & 15, cc = c & 31, ob = rr * 64 + cc * 2; return st * 1024 + (ob ^ (((ob >> 9) & 1) << 5)); }
__host__ __device__ __forceinline__ void stage_rc(int b, int& R, int& C) { const int st = b / 1024, sb = b % 1024, swz = sb ^ (((sb >> 9) & 1) << 5); R = (st >> 1) * 16 + swz / 64; C = (st & 1) * 32 + (swz % 64) / 2; }
__host__ __device__ __forceinline__ int perm32(int rho) { const int n = rho >> 4, i = rho & 15; return 8 * (i >> 2) + 4 * n + (i & 3); }

struct Unit { const char* A; const char* B; int pm, pn, kind, nt; };

__device__ __forceinline__ void tile_order(int L, int nM, int nN, int& pm, int& pn) {
    const int nwg = nM * nN; int wgid = L;
    { const int q = nwg / NXCD, r = nwg % NXCD, xcd = wgid % NXCD, off = wgid / NXCD; wgid = (xcd < r ? xcd * (q + 1) : r * (q + 1) + (xcd - r) * q) + off; }
    const int nig = WGM * nN, gid = wgid / nig, fm = gid * WGM, gsz = (nM - fm) < WGM ? (nM - fm) : WGM;
    pm = fm + ((wgid % nig) % gsz); pn = (wgid % nig) / gsz;
}

template <class Sched> __device__ __forceinline__ void prestage_B(LAS unsigned char* lds, const int pitchB, const Sched& S) {
    Unit u; if (!S.next(0, u)) return;
    const int tid = fresh_tid(), wid = __builtin_amdgcn_readfirstlane(tid >> 6);
    unsigned voffB[2];
#pragma unroll
    for (int i = 0; i < 2; ++i) { int R, C; stage_rc(tid * 16 + i * 8192, R, C); const int Rb = (R & ~31) + perm32(R & 31); voffB[i] = (unsigned)(Rb * pitchB + C) * 2u; }
    const size_t hstepB = (size_t)HALF * pitchB * 2; const unsigned ldsw = (unsigned)wid * 1024u;
#pragma unroll
    for (int h = 0; h < 2; ++h)
#pragma unroll
        for (int i = 0; i < 2; ++i)
            __builtin_amdgcn_global_load_lds((const unsigned*)(u.B + h * hstepB + voffB[i]), (LAS unsigned*)(lds + (4 + h) * HTB + ldsw + i * 8192), 16, 0, 0);
}
template <class Epi, class Sched, bool ALIGN_EPI, bool SP2, bool BPRE = false>
__device__ __forceinline__ void gemm_phase(LAS unsigned char* lds, const int pitchA, const int pitchB, const Sched& S, const Epi& E) {
    const int tid = fresh_tid(), wid = __builtin_amdgcn_readfirstlane(tid >> 6), lane = tid & 63, wr = wid >> 2, wc = wid & 3, fr = lane & 15, fq = lane >> 4;
    unsigned voffA[2], voffB[2];
#pragma unroll
    for (int i = 0; i < 2; ++i) { int R, C; stage_rc(tid * 16 + i * 8192, R, C); const int Rb = (R & ~31) + perm32(R & 31);
        voffA[i] = (unsigned)(R * pitchA + C) * 2u; voffB[i] = (unsigned)(Rb * pitchB + C) * 2u; }
    const size_t kstep = (size_t)(BK * 2);
    const size_t hstepA = (size_t)HALF * pitchA * 2, hstepB = (size_t)HALF * pitchB * 2;
    const unsigned ldsw = (unsigned)wid * 1024u;
    const int aoff = lds_byte(wr * 64 + fr, fq * 8), boff = lds_byte(wc * 32 + fr, fq * 8);
#define PG8_SA(b, h) (((b) * 2 + (h)) * HTB)
#define PG8_SB(b, h) ((4 + (b) * 2 + (h)) * HTB)
#define PG8_STAGE(bufoff, gbase, voff) do { _Pragma("unroll") for (int _i = 0; _i < 2; ++_i) \
        __builtin_amdgcn_global_load_lds((const unsigned*)((const char*)(gbase) + (voff)[_i]), (LAS unsigned*)(lds + (bufoff) + ldsw + _i * 8192), 16, 0, 0); } while (0)
#define PG8_LDA(dst, b, h) do { _Pragma("unroll") for (int m = 0; m < 4; ++m) _Pragma("unroll") for (int k = 0; k < 2; ++k) dst[m][k] = *(const LAS bf16x8*)(lds + PG8_SA(b, h) + aoff + m * 2048 + k * 1024); } while (0)
#define PG8_LDB(dst, b, h) do { _Pragma("unroll") for (int n = 0; n < 2; ++n) _Pragma("unroll") for (int k = 0; k < 2; ++k) dst[n][k] = *(const LAS bf16x8*)(lds + PG8_SB(b, h) + boff + n * 2048 + k * 1024); } while (0)
#define PG8_MMA(ai, bj, At, Bt) do { __builtin_amdgcn_s_setprio(1); _Pragma("unroll") for (int m = 0; m < 4; ++m) _Pragma("unroll") for (int n = 0; n < 2; ++n) _Pragma("unroll") for (int k = 0; k < 2; ++k) \
        acc[ai][bj][m][n] = __builtin_amdgcn_mfma_f32_16x16x32_bf16(Bt[n][k], At[m][k], acc[ai][bj][m][n], 0, 0, 0); __builtin_amdgcn_s_setprio(0); } while (0)
#define PG8_WAIT_V(n) asm volatile("s_waitcnt vmcnt(" #n ")" ::: "memory")
#define PG8_WAIT_L(n) asm volatile("s_waitcnt lgkmcnt(" #n ")" ::: "memory")
#define PG8_BAR __builtin_amdgcn_s_barrier()
#define PG8_SCHED __builtin_amdgcn_sched_barrier(0)
    Unit cur, nxt; int ui = 0;
    if (!S.next(0, cur)) return;
    f32x4 acc[2][2][4][2];
#pragma unroll
    for (int a = 0; a < 2; ++a)
#pragma unroll
        for (int b = 0; b < 2; ++b)
#pragma unroll
            for (int m = 0; m < 4; ++m)
#pragma unroll
                for (int n = 0; n < 2; ++n) acc[a][b][m][n] = (f32x4){0.f, 0.f, 0.f, 0.f};
    bf16x8 At[4][2], B0[2][2], B1[2][2];
    const char* cA = cur.A; const char* cB = cur.B;
    if constexpr (SP2) {
        if constexpr (!BPRE) { PG8_STAGE(PG8_SB(0, 0), cB, voffB); PG8_STAGE(PG8_SB(0, 1), cB + hstepB, voffB); }
        PG8_STAGE(PG8_SA(0, 0), cA, voffA); PG8_STAGE(PG8_SA(0, 1), cA + hstepA, voffA);
        if (wr == 1) PG8_BAR;
        PG8_WAIT_V(2); PG8_BAR;
        PG8_STAGE(PG8_SB(1, 0), cB + kstep, voffB); PG8_STAGE(PG8_SA(1, 0), cA + kstep, voffA); PG8_STAGE(PG8_SB(1, 1), cB + hstepB + kstep, voffB);
        PG8_WAIT_V(6); PG8_BAR;
    } else {
        PG8_STAGE(PG8_SB(0, 0), cB, voffB); PG8_STAGE(PG8_SA(0, 0), cA, voffA); PG8_STAGE(PG8_SB(0, 1), cB + hstepB, voffB); PG8_STAGE(PG8_SA(0, 1), cA + hstepA, voffA);
        if (wr == 1) PG8_BAR;
        PG8_WAIT_V(4); PG8_BAR;
        PG8_STAGE(PG8_SB(1, 0), cB + kstep, voffB); PG8_STAGE(PG8_SA(1, 0), cA + kstep, voffA); PG8_STAGE(PG8_SB(1, 1), cB + hstepB + kstep, voffB);
        PG8_WAIT_V(6); PG8_BAR;
    }
    for (;;) {
        const bool has_next = S.next(ui + 1, nxt);
        const char* nA = has_next ? nxt.A : cA; const char* nB = has_next ? nxt.B : cB;
        const int nt = cur.nt;
#pragma unroll 1
        for (int t = 0; t < nt; t += 2) {
            const bool last = (t == nt - 2);
            const char* a1 = cA + (size_t)(t + 1) * kstep;
            const char* a2 = last ? nA : cA + (size_t)(t + 2) * kstep; const char* b2 = last ? nB : cB + (size_t)(t + 2) * kstep;
            const char* a3 = a2 + kstep; const char* b3 = b2 + kstep;
            if constexpr (SP2) {
            PG8_LDB(B0, 0, 0); PG8_LDB(B1, 0, 1); PG8_SCHED; PG8_LDA(At, 0, 0); PG8_STAGE(PG8_SA(1, 1), a1 + hstepA, voffA);
            PG8_WAIT_V(8); PG8_WAIT_L(0); PG8_BAR; PG8_MMA(0, 0, At, B0); PG8_MMA(0, 1, At, B1); PG8_BAR; PG8_SCHED;
            PG8_LDA(At, 0, 1); PG8_STAGE(PG8_SB(0, 0), b2, voffB); PG8_STAGE(PG8_SB(0, 1), b2 + hstepB, voffB); PG8_STAGE(PG8_SA(0, 0), a2, voffA);
            PG8_WAIT_V(8); PG8_WAIT_L(0); PG8_BAR; PG8_MMA(1, 0, At, B0); PG8_MMA(1, 1, At, B1); PG8_BAR; PG8_SCHED;
            PG8_LDB(B0, 1, 0); PG8_LDB(B1, 1, 1); PG8_SCHED; PG8_LDA(At, 1, 0); PG8_STAGE(PG8_SA(0, 1), a2 + hstepA, voffA);
            PG8_WAIT_V(8); PG8_WAIT_L(0); PG8_BAR; PG8_MMA(0, 0, At, B0); PG8_MMA(0, 1, At, B1); PG8_BAR; PG8_SCHED;
            PG8_LDA(At, 1, 1); PG8_STAGE(PG8_SB(1, 0), b3, voffB); PG8_STAGE(PG8_SB(1, 1), b3 + hstepB, voffB); PG8_STAGE(PG8_SA(1, 0), a3, voffA);
            PG8_WAIT_V(8); PG8_WAIT_L(0); PG8_BAR; PG8_MMA(1, 0, At, B0); PG8_MMA(1, 1, At, B1); PG8_BAR; PG8_SCHED;
            } else {
            PG8_LDB(B0, 0, 0); PG8_SCHED; PG8_LDA(At, 0, 0); PG8_STAGE(PG8_SA(1, 1), a1 + hstepA, voffA);
            PG8_WAIT_L(8); PG8_BAR; PG8_WAIT_L(0); PG8_MMA(0, 0, At, B0); PG8_BAR; PG8_SCHED;
            PG8_LDB(B1, 0, 1); PG8_STAGE(PG8_SB(0, 0), b2, voffB);
            PG8_BAR; PG8_WAIT_L(0); PG8_MMA(0, 1, At, B1); PG8_BAR;
            PG8_LDA(At, 0, 1); PG8_STAGE(PG8_SA(0, 0), a2, voffA);
            PG8_BAR; PG8_WAIT_L(0); PG8_MMA(1, 0, At, B0); PG8_BAR; PG8_SCHED;
            PG8_STAGE(PG8_SB(0, 1), b2 + hstepB, voffB);
            PG8_WAIT_V(6); PG8_BAR; PG8_MMA(1, 1, At, B1); PG8_BAR;
            PG8_LDB(B0, 1, 0); PG8_SCHED; PG8_LDA(At, 1, 0); PG8_STAGE(PG8_SA(0, 1), a2 + hstepA, voffA);
            PG8_WAIT_L(8); PG8_BAR; PG8_WAIT_L(0); PG8_MMA(0, 0, At, B0); PG8_BAR; PG8_SCHED;
            PG8_LDB(B1, 1, 1); PG8_STAGE(PG8_SB(1, 0), b3, voffB);
            PG8_BAR; PG8_WAIT_L(0); PG8_MMA(0, 1, At, B1); PG8_BAR;
            PG8_LDA(At, 1, 1); PG8_STAGE(PG8_SA(1, 0), a3, voffA);
            PG8_BAR; PG8_WAIT_L(0); PG8_MMA(1, 0, At, B0); PG8_BAR; PG8_SCHED;
            PG8_STAGE(PG8_SB(1, 1), b3 + hstepB, voffB);
            PG8_WAIT_V(6); PG8_BAR; PG8_MMA(1, 1, At, B1); PG8_BAR;
            }
        }
        if constexpr (ALIGN_EPI) { if (wr == 0) PG8_BAR; }
        E(acc, cur, wr, wc, fr, fq);
        if (!has_next) break;
#pragma unroll
        for (int a = 0; a < 2; ++a)
#pragma unroll
            for (int b = 0; b < 2; ++b)
#pragma unroll
                for (int m = 0; m < 4; ++m)
#pragma unroll
                    for (int n = 0; n < 2; ++n) acc[a][b][m][n] = (f32x4){0.f, 0.f, 0.f, 0.f};
        cur = nxt; cA = nA; cB = nB; ++ui;
        if constexpr (ALIGN_EPI) { if (wr == 1) PG8_BAR; }
    }
    PG8_WAIT_V(0);
    if constexpr (!ALIGN_EPI) { if (wr == 0) PG8_BAR; }
    PG8_BAR;
#undef PG8_SA
#undef PG8_SB
#undef PG8_STAGE
#undef PG8_LDA
#undef PG8_LDB
#undef PG8_MMA
#undef PG8_WAIT_V
#undef PG8_WAIT_L
#undef PG8_BAR
#undef PG8_SCHED
}
}
using pg8::Unit;

struct Args { const float* in[21]; float* out; unsigned char* ws; };
struct Frame {
    LAS unsigned char* lds;
    int tid, lane, wave, vcu, G;
    const float* in[21]; float* out; unsigned char* ws;
};
typedef const __attribute__((address_space(4))) Args KArgs;
__device__ __forceinline__ Frame make_frame(LAS unsigned char* lds) {
    Frame F; F.lds = lds;
    F.tid = fresh_tid(); F.lane = F.tid & 63; F.wave = __builtin_amdgcn_readfirstlane(F.tid >> 6);
    F.G = gridDim.x; { const int bx = blockIdx.x; F.vcu = (F.G % 8 == 0) ? (bx % 8) * (F.G / 8) + bx / 8 : bx; }
    KArgs* ka = (KArgs*)__builtin_amdgcn_kernarg_segment_ptr(); asm volatile("" : "+s"(ka));
#pragma unroll
    for (int i = 0; i < 21; ++i) F.in[i] = ka->in[i];
    F.out = ka->out; F.ws = ka->ws;
    return F;
}
#define WSP(T, off) ((T*)(F.ws + (off)))

__device__ __forceinline__ void p0_transpose_item(const float* Wsrc  , int ldw, bf16_t* dst  , int ldt, LAS float* scr, int lane) {
    const int r = lane >> 4, c4 = lane & 15;
    f32x4 v[16];
#pragma unroll
    for (int i = 0; i < 16; ++i) v[i] = __builtin_nontemporal_load((const GAS f32x4*)(Wsrc + (size_t)(4 * i + r) * ldw + 4 * c4));
#pragma unroll
    for (int i = 0; i < 16; ++i) { LAS float* s = scr + (4 * i + r) * 65 + 4 * c4; s[0] = v[i].x; s[1] = v[i].y; s[2] = v[i].z; s[3] = v[i].w; }
    LDS_WAIT(); asm volatile("" ::: "memory");
    const int c = lane & 7;
#pragma unroll
    for (int j = 0; j < 8; ++j) { const int n = (lane >> 3) + 8 * j; const LAS float* s = scr + (8 * c) * 65 + n;
        u32x4 o; o.x = cvt_pk_bf16(s[0 * 65], s[1 * 65]); o.y = cvt_pk_bf16(s[2 * 65], s[3 * 65]); o.z = cvt_pk_bf16(s[4 * 65], s[5 * 65]); o.w = cvt_pk_bf16(s[6 * 65], s[7 * 65]);
        *(GAS u32x4*)(dst + (size_t)n * ldt + 8 * c) = o; }
    LDS_WAIT(); asm volatile("" ::: "memory");
}
__device__ __forceinline__ void rms_row_to_bf16(const float* xrow, const float* g, bf16_t* orow, int lane) {
    const GAS f32x4* xr = (const GAS f32x4*)xrow + lane;
    f32x4 v[16], gv[16]; float s = 0.f;
    const GAS f32x4* gr = (const GAS f32x4*)g + lane;
#pragma unroll
    for (int j = 0; j < 16; ++j) v[j] = __builtin_nontemporal_load(xr + 64 * j);
#pragma unroll
    for (int j = 0; j < 16; ++j) gv[j] = gr[64 * j];
#pragma unroll
    for (int j = 0; j < 16; ++j) s += (v[j].x * v[j].x + v[j].y * v[j].y) + (v[j].z * v[j].z + v[j].w * v[j].w);
    const float rstd = 1.0f / sqrtf(wave_sum(s) * (1.0f / DM) + EPS);
    GAS u32x2* o8 = (GAS u32x2*)orow + lane;
#pragma unroll
    for (int j = 0; j < 16; ++j) { const f32x4 gg = gv[j]; u32x2 w; w.x = cvt_pk_bf16(v[j].x * rstd * gg.x, v[j].y * rstd * gg.y); w.y = cvt_pk_bf16(v[j].z * rstd * gg.z, v[j].w * rstd * gg.w); o8[64 * j] = w; }
}
__device__ __forceinline__ int win_src_col(int np) { const int t = np >> 8, i = np & 255; return (t >= 12 && t < 24) ? ((i < 128) ? 3072 + 128 * (t - 12) + i : 4608 + 128 * (t - 12) + (i - 128)) : np; }

constexpr int I_IN = 64 * 152, I_KV = 64 * 16, I_OUT = 64 * 64, I_PW = 24 * 24, I_PL = 6 * 6;
constexpr int NITEMS_EARLY = I_IN + 2 * I_KV, NITEMS = NITEMS_EARLY + I_OUT + I_PW + 4 * I_PL;
__device__ __forceinline__ void p0_items(Frame& F, int first, int last, int gw, int NGW) {
    LAS float* scr = (LAS float*)(F.lds + F.wave * 16640);
    bf16_t* WIN = WSP(bf16_t, WS_WIN); bf16_t* WKV = WSP(bf16_t, WS_WKV); bf16_t* WOUT = WSP(bf16_t, WS_WOUT); bf16_t* WPW = WSP(bf16_t, WS_WPW); bf16_t* WPOOL = WSP(bf16_t, WS_WPOOL);
    for (int it = first + gw; it < last; it += NGW) {
        int r = it; const float* src; bf16_t* dst; int ldw, ldt;
        if (r < I_IN) { const int kb = r / 152, nb = r % 152; src = F.in[9] + (size_t)(64 * kb) * DIN + win_src_col(64 * nb); ldw = DIN; dst = WIN + (size_t)(64 * nb) * DM + 64 * kb; ldt = DM; }
        else if ((r -= I_IN) < I_KV) { const int kb = r / 16, nb = r % 16; src = F.in[10] + (size_t)(64 * kb) * DX + 64 * nb; ldw = DX; dst = WKV + (size_t)(64 * nb) * DM + 64 * kb; ldt = DM; }
        else if ((r -= I_KV) < I_KV) { const int kb = r / 16, nb = r % 16; src = F.in[11] + (size_t)(64 * kb) * DX + 64 * nb; ldw = DX; dst = WKV + (size_t)(1024 + 64 * nb) * DM + 64 * kb; ldt = DM; }
        else if ((r -= I_KV) < I_OUT) { const int kb = r / 64, nb = r % 64; src = F.in[19] + (size_t)(64 * kb) * DM + 64 * nb; ldw = DM; dst = WOUT + (size_t)(64 * nb) * DM + 64 * kb; ldt = DM; }
        else if ((r -= I_OUT) < I_PW) { const int kb = r / 24, nb = r % 24; src = F.in[18] + (size_t)(64 * kb) * DCONV + 64 * nb; ldw = DCONV; dst = WPW + (size_t)(64 * nb) * DCONV + 64 * kb; ldt = DCONV; }
        else { r -= I_PW; const int g = r / I_PL, q = r % I_PL, kb = q / 6, nb = q % 6;
            src = F.in[12] + (size_t)g * PGRP * PGRP + (size_t)(64 * kb) * PGRP + 64 * nb; ldw = PGRP; dst = WPOOL + (size_t)g * 512 * PGRP + (size_t)(64 * nb) * PGRP + 64 * kb; ldt = PGRP; }
        p0_transpose_item(src, ldw, dst, ldt, scr, F.lane);
    }
}
__device__ __forceinline__ void p0_pool_pad(Frame& F, int gt, int NGT) {
    bf16_t* WPOOL = WSP(bf16_t, WS_WPOOL);
    for (int i = gt; i < 4 * 6144; i += NGT) { const int g = i / 6144, q = i % 6144; *(GAS u32x4*)(WPOOL + (size_t)g * 512 * PGRP + (size_t)384 * PGRP + (size_t)q * 8) = (u32x4){0u, 0u, 0u, 0u}; }
}
__device__ __forceinline__ void p0_pool_frag(Frame& F, int gt, int NGT) {
    bf16_t* WF = WSP(bf16_t, WS_WPOOLF);
    for (int i = gt; i < 4 * 24 * 12 * 64; i += NGT) { const int l = i & 63, blk = i >> 6, ks = blk % 12, nt = (blk / 12) % 24, g = blk / 288;
        const float* src = F.in[12] + (size_t)g * PGRP * PGRP + (size_t)(32 * ks + 8 * (l >> 4)) * PGRP + 16 * nt + (l & 15);
        float v[8];
#pragma unroll
        for (int e = 0; e < 8; ++e) v[e] = *(const GAS float*)(src + (size_t)e * PGRP);
        *(GAS u32x4*)(WF + (size_t)i * 8) = (u32x4){cvt_pk_bf16(v[0], v[1]), cvt_pk_bf16(v[2], v[3]), cvt_pk_bf16(v[4], v[5]), cvt_pk_bf16(v[6], v[7])}; }
}
__device__ __forceinline__ void p0_prologue(Frame& F, bool all_weights) {
    const int gw = F.vcu * NWAVES + F.wave, NGW = F.G * NWAVES;
    p0_items(F, 0, all_weights ? NITEMS : NITEMS_EARLY, gw, NGW);
    if (all_weights) { p0_pool_pad(F, F.vcu * NTHR + F.tid, F.G * NTHR); p0_pool_frag(F, F.vcu * NTHR + F.tid, F.G * NTHR); }
    bf16_t* H = WSP(bf16_t, WS_H); bf16_t* HM = WSP(bf16_t, WS_HM);
    for (int m = gw; m < MT + MM; m += NGW) {
        if (m < MP) rms_row_to_bf16(F.in[0] + (size_t)m * DM, F.in[7], H + (size_t)m * DM, F.lane);
        else if (m < MT) rms_row_to_bf16(F.in[2] + (size_t)(m - MP) * DM, F.in[7], H + (size_t)m * DM, F.lane);
        else rms_row_to_bf16(F.in[1] + (size_t)(m - MT) * DM, F.in[8], HM + (size_t)(m - MT) * DM, F.lane);
    }
}

constexpr int G1_NM = MT / 256, G1_NN = DIN / 256, G1_IN = G1_NM * G1_NN, G1_ALL = G1_IN + 48;
constexpr size_t TSTEP4K = (size_t)256 * DM * 2;
constexpr int G1_SPECIAL = 16, G1_PROMPT = (MP / 256) * G1_NN, G1_S2 = 60;
struct Sched1 {
    int G, c; const char *H, *HM, *WIN, *WKV;
    __device__ __forceinline__ bool next(int i, Unit& u) const {
        int L = i * G + c; if (L >= G1_ALL) return false;
        u.nt = DM / 64; u.kind = 0;
        if (L < G1_SPECIAL) { u.pm = MP / 256 + (L >> 3); u.pn = 30 + (L & 7); u.kind = 4; }
        else if ((L -= G1_SPECIAL) < G1_PROMPT) { int pm, pn; pg8::tile_order(L, MP / 256, G1_NN, pm, pn); u.pm = pm; u.pn = pn; }
        else if ((L -= G1_PROMPT) < G1_S2) { u.pm = MP / 256 + L / 30; u.pn = L % 30; }
        else { const int r = L - G1_S2, t = r >> 4, pm = (r >> 2) & 3, pn = r & 3; u.pm = pm; u.pn = pn; u.kind = 1 + t;
            if (t == 0) { u.A = HM + (size_t)pm * TSTEP4K; u.B = WKV + (size_t)pn * TSTEP4K; }
            else if (t == 1) { u.A = HM + (size_t)pm * TSTEP4K; u.B = WKV + (size_t)(4 + pn) * TSTEP4K; }
            else { u.A = WKV + (size_t)(4 + pm) * TSTEP4K; u.B = HM + (size_t)pn * TSTEP4K; }
            return true; }
        u.A = H + (size_t)u.pm * TSTEP4K; u.B = WIN + (size_t)u.pn * TSTEP4K;
        return true;
    }
};
struct Epi1 {
    bf16_t *U, *SGA, *A, *SGB, *Q, *SGC, *KP, *VPT; float *outK, *outV; unsigned* qready;
    __device__ __forceinline__ void operator()(const f32x4 (&acc)[2][2][4][2], const Unit& u, int wr, int wc, int fr, int fq) const {
        const int row0 = u.pm * 256 + wr * 64 + fr, cl = wc * 32 + 8 * fq;
        if (u.kind == 0 || u.kind == 4) {
            const int pn = u.pn;
            if (pn >= 12 && pn < 24) {
                bf16_t* base = A + (size_t)row0 * DCONV + (pn - 12) * 128 + cl;
#pragma unroll
                for (int ai = 0; ai < 2; ++ai)
#pragma unroll
                    for (int m = 0; m < 4; ++m) { const f32x4 v0 = acc[ai][0][m][0], v1 = acc[ai][0][m][1], g0 = acc[ai][1][m][0], g1 = acc[ai][1][m][1];
                        u32x4 w; w.x = cvt_pk_bf16(v0[0] * fast_sigmoid(g0[0]), v0[1] * fast_sigmoid(g0[1])); w.y = cvt_pk_bf16(v0[2] * fast_sigmoid(g0[2]), v0[3] * fast_sigmoid(g0[3]));
                        w.z = cvt_pk_bf16(v1[0] * fast_sigmoid(g1[0]), v1[1] * fast_sigmoid(g1[1])); w.w = cvt_pk_bf16(v1[2] * fast_sigmoid(g1[2]), v1[3] * fast_sigmoid(g1[3]));
                        *(u32x4*)(base + (size_t)(ai * 128 + m * 16) * DCONV) = w; }
            } else {
                bf16_t* dst; int ldc, colt; bool act;
                if (pn < 6) { dst = U; ldc = DPOOL; colt = pn * 256; act = false; }
                else if (pn < 12) { dst = SGA; ldc = DPOOL; colt = (pn - 6) * 256; act = true; }
                else if (pn < 30) { dst = SGB; ldc = DCONV; colt = (pn - 24) * 256; act = true; }
                else if (pn < 34) { dst = Q; ldc = DX; colt = (pn - 30) * 256; act = false; }
                else { dst = SGC; ldc = DX; colt = (pn - 34) * 256; act = true; }
                bf16_t* base = dst + (size_t)row0 * ldc + colt + cl;
#pragma unroll
                for (int ai = 0; ai < 2; ++ai)
#pragma unroll
                    for (int m = 0; m < 4; ++m)
#pragma unroll
                        for (int bj = 0; bj < 2; ++bj) { f32x4 v0 = acc[ai][bj][m][0], v1 = acc[ai][bj][m][1];
                            if (act) {
#pragma unroll
                                for (int j = 0; j < 4; ++j) { v0[j] = fast_silu(v0[j]); v1[j] = fast_silu(v1[j]); } }
                            u32x4 w; w.x = cvt_pk_bf16(v0[0], v0[1]); w.y = cvt_pk_bf16(v0[2], v0[3]); w.z = cvt_pk_bf16(v1[0], v1[1]); w.w = cvt_pk_bf16(v1[2], v1[3]);
                            *(u32x4*)(base + (size_t)(ai * 128 + m * 16) * ldc + bj * 128) = w; }
            }
        } else if (u.kind == 3) {
            bf16_t* base = VPT + (size_t)row0 * 1024 + u.pn * 256 + cl;
#pragma unroll
            for (int ai = 0; ai < 2; ++ai)
#pragma unroll
                for (int m = 0; m < 4; ++m)
#pragma unroll
                    for (int bj = 0; bj < 2; ++bj) { const f32x4 v0 = acc[ai][bj][m][0], v1 = acc[ai][bj][m][1];
                        u32x4 w; w.x = cvt_pk_bf16(v0[0], v0[1]); w.y = cvt_pk_bf16(v0[2], v0[3]); w.z = cvt_pk_bf16(v1[0], v1[1]); w.w = cvt_pk_bf16(v1[2], v1[3]);
                        *(u32x4*)(base + (size_t)(ai * 128 + m * 16) * 1024 + bj * 128) = w; }
        } else {
            float* fb = (u.kind == 1 ? outK : outV) + (size_t)row0 * 1024 + u.pn * 256 + cl;
            bf16_t* kb = KP + (size_t)row0 * 1024 + u.pn * 256 + cl;
            const bool wk = (u.kind == 1);
#pragma unroll
            for (int ai = 0; ai < 2; ++ai)
#pragma unroll
                for (int m = 0; m < 4; ++m)
#pragma unroll
                    for (int bj = 0; bj < 2; ++bj) { const f32x4 v0 = acc[ai][bj][m][0], v1 = acc[ai][bj][m][1];
                        float* p = fb + (size_t)(ai * 128 + m * 16) * 1024 + bj * 128; *(f32x4*)p = v0; *(f32x4*)(p + 4) = v1;
                        if (wk) { u32x4 w; w.x = cvt_pk_bf16(v0[0], v0[1]); w.y = cvt_pk_bf16(v0[2], v0[3]); w.z = cvt_pk_bf16(v1[0], v1[1]); w.w = cvt_pk_bf16(v1[2], v1[3]);
                            *(u32x4*)(kb + (size_t)(ai * 128 + m * 16) * 1024 + bj * 128) = w; } }
        }
        if (u.kind == 4) {
            asm volatile("s_waitcnt vmcnt(0)" ::: "memory"); __builtin_amdgcn_s_barrier(); asm volatile("" ::: "memory");
            if (threadIdx.x == 0) { __builtin_amdgcn_fence(__ATOMIC_RELEASE, "agent"); asm volatile("s_waitcnt vmcnt(0)" ::: "memory");
                __hip_atomic_fetch_add(qready, 1u, __ATOMIC_RELAXED, __HIP_MEMORY_SCOPE_AGENT); } }
    }
};

__device__ __forceinline__ f32x4 ld_bf4(const bf16_t* p) { const u32x2 w = *(const GAS u32x2*)p; return (f32x4){bf_lo(w.x), bf_hi(w.x), bf_lo(w.y), bf_hi(w.y)}; }
__device__ __forceinline__ void states_copy_rows(Frame& F, int gw, int NGW) {
    constexpr int KP_ = PSTATE - DS, KC_ = CSTATE - DS, R_P = DB * KP_, R_C = DB * KC_;
    const unsigned ln = (unsigned)F.lane;
    for (int i = gw; i < R_P + R_C; i += NGW) {
        const float* sf; float* dst;
        if (i < R_P) { const int b = i / KP_, j = i % KP_; sf = F.in[5] + (size_t)(b * PSTATE + j + DS) * DPOOL; dst = F.out + O_PSS + (size_t)(b * PSTATE + j) * DPOOL; }
        else { const int r = i - R_P, b = r / KC_, j = r % KC_; sf = F.in[6] + (size_t)(b * CSTATE + j + DS) * DCONV; dst = F.out + O_CSS + (size_t)(b * CSTATE + j) * DCONV; }
        f32x4 v[6];
#pragma unroll
        for (int k = 0; k < 6; ++k) v[k] = ldg<f32x4>(sf, (256u * k + 4u * ln) * 4u);
#pragma unroll
        for (int k = 0; k < 6; ++k) *(GAS f32x4*)((char*)dst + (256u * k + 4u * ln) * 4u) = v[k];
    }
}
__device__ __forceinline__ void p2_states(Frame& F) {
    const bf16_t* U = WSP(bf16_t, WS_U); const bf16_t* A = WSP(bf16_t, WS_A);
    constexpr int R_PSP = NB * PSTATE, R_CSP = NB * CSTATE, R_S = DB * DS;
    const unsigned ln = (unsigned)F.lane;
    for (int i = F.vcu * NWAVES + F.wave; i < R_PSP + R_CSP + 2 * R_S; i += F.G * NWAVES) {
        int r = i; const bf16_t* sb; float* dst;
        if (r < R_PSP) { const int j = r % PSTATE, b = r / PSTATE; sb = U + (size_t)(b * SEQ + SEQ - PSTATE + j) * DPOOL; dst = F.out + O_PSP + (size_t)r * DPOOL; }
        else if ((r -= R_PSP) < R_CSP) { const int j = r % CSTATE, b = r / CSTATE; sb = A + (size_t)(b * SEQ + SEQ - CSTATE + j) * DCONV; dst = F.out + O_CSP + (size_t)r * DCONV; }
        else if ((r -= R_CSP) < R_S) { const int b = r >> 2, t = r & 3; sb = U + (size_t)(MP + r) * DPOOL; dst = F.out + O_PSS + (size_t)(b * PSTATE + PSTATE - DS + t) * DPOOL; }
        else { r -= R_S; const int b = r >> 2, t = r & 3; sb = A + (size_t)(MP + r) * DCONV; dst = F.out + O_CSS + (size_t)(b * CSTATE + CSTATE - DS + t) * DCONV; }
        f32x4 v[6];
#pragma unroll
        for (int k = 0; k < 6; ++k) { const u32x2 w = ldg<u32x2>(sb, (256u * k + 4u * ln) * 2u); v[k] = (f32x4){bf_lo(w.x), bf_hi(w.x), bf_lo(w.y), bf_hi(w.y)}; }
#pragma unroll
        for (int k = 0; k < 6; ++k) *(GAS f32x4*)((char*)dst + (256u * k + 4u * ln) * 4u) = v[k];
    }
}
template <int W, bool SAMPLE> __device__ __forceinline__ void pool_task(Frame& F, int r0  , int c  , size_t src_off = WS_U, size_t dst_off = WS_POOLED) {
    const bf16_t* U = WSP(bf16_t, src_off); bf16_t* P = WSP(bf16_t, dst_off);
    constexpr bool sample = SAMPLE;
    const int pos0 = sample ? 0 : (r0 & (SEQ - 1));
    const int bs = (r0 - MP) >> 2;
    float x[W + 3][8];
#pragma unroll
    for (int i = 0; i < W + 3; ++i) {
        const int rr = i - (W - 1);
        if (rr >= 0 || (!sample && pos0 + rr >= 0)) { const u32x4 w = *(const GAS u32x4*)(U + (size_t)(r0 + rr) * DPOOL + c);
            x[i][0] = bf_lo(w.x); x[i][1] = bf_hi(w.x); x[i][2] = bf_lo(w.y); x[i][3] = bf_hi(w.y); x[i][4] = bf_lo(w.z); x[i][5] = bf_hi(w.z); x[i][6] = bf_lo(w.w); x[i][7] = bf_hi(w.w); }
        else if (sample) { const float* sp = F.in[5] + ((size_t)bs * PSTATE + (PSTATE + rr)) * DPOOL + c; const f32x4 a = *(const GAS f32x4*)sp, b = *(const GAS f32x4*)(sp + 4);
            x[i][0] = a.x; x[i][1] = a.y; x[i][2] = a.z; x[i][3] = a.w; x[i][4] = b.x; x[i][5] = b.y; x[i][6] = b.z; x[i][7] = b.w; }
        else {
#pragma unroll
            for (int e = 0; e < 8; ++e) x[i][e] = 0.f; }
    }
#pragma unroll
    for (int tk = 0; tk < 4; ++tk) {
        float s[8];
#pragma unroll
        for (int e = 0; e < 8; ++e) s[e] = 0.f;
#pragma unroll
        for (int i = 0; i < W; ++i)
#pragma unroll
            for (int e = 0; e < 8; ++e) s[e] += x[tk + i][e];
        const int pos = pos0 + tk; const float inv = sample ? (1.0f / W) : 1.0f / (float)((pos + 1 < W) ? pos + 1 : W);
        u32x4 o; o.x = cvt_pk_bf16(s[0] * inv - x[tk + W - 1][0], s[1] * inv - x[tk + W - 1][1]); o.y = cvt_pk_bf16(s[2] * inv - x[tk + W - 1][2], s[3] * inv - x[tk + W - 1][3]);
        o.z = cvt_pk_bf16(s[4] * inv - x[tk + W - 1][4], s[5] * inv - x[tk + W - 1][5]); o.w = cvt_pk_bf16(s[6] * inv - x[tk + W - 1][6], s[7] * inv - x[tk + W - 1][7]);
        *(GAS u32x4*)(P + (size_t)(r0 + tk) * DPOOL + c) = o;
    }
}
__device__ __forceinline__ void p2_pool_sample_task(Frame& F, int sidx) {
    const int R0 = (256 + sidx / 24) * 32, id = sidx % 24, g = id / 6, q = id % 6, third = q >> 1, half = q & 1;
    const int r0 = R0 + 16 * half + 4 * (F.lane >> 4), c = g * PGRP + third * 128 + (F.lane & 15) * 8;
    if (g == 0) pool_task<2, true>(F, r0, c); else if (g == 1) pool_task<4, true>(F, r0, c); else if (g == 2) pool_task<8, true>(F, r0, c); else pool_task<16, true>(F, r0, c);
}
constexpr int PL_ROWS = 32 + PSTATE, PL_STAGE = PL_ROWS * DPOOL * 2;
__device__ __forceinline__ void lds_row8(const LAS unsigned char* p, float (&x)[8]) { const u32x4 w = *(const LAS u32x4*)p;
    x[0] = bf_lo(w.x); x[1] = bf_hi(w.x); x[2] = bf_lo(w.y); x[3] = bf_hi(w.y); x[4] = bf_lo(w.z); x[5] = bf_hi(w.z); x[6] = bf_lo(w.w); x[7] = bf_hi(w.w); }
__device__ __forceinline__ void p2_pool_unit_prompt(Frame& F, int unit, int sidx = -1) {
    LAS unsigned char* S = F.lds;
    const bf16_t* U = WSP(bf16_t, WS_U); bf16_t* P = WSP(bf16_t, WS_POOLED);
    unsigned tid = (unsigned)F.tid; asm volatile("" : "+v"(tid));
    const unsigned ln = tid & 63u;
    const int R0 = unit * 32, pos_u = (unit & 63) * 32;
#pragma unroll 1
    for (int i = F.wave; i < PL_ROWS * 3; i += NWAVES) { const int row = i / 3, th = i - 3 * row, rel = row - PSTATE;
        if (pos_u + rel >= 0) __builtin_amdgcn_global_load_lds((const unsigned*)((const char*)(U + (size_t)(R0 + rel) * DPOOL) + th * 1024 + ln * 16u), (LAS unsigned*)(S + i * 1024), 16, 0, 0);
        else *(LAS u32x4*)(S + i * 1024 + ln * 16u) = (u32x4){0u, 0u, 0u, 0u}; }
    if (sidx >= 0 && sidx < 16 * 24) p2_pool_sample_task(F, sidx);
    asm volatile("s_waitcnt vmcnt(0) lgkmcnt(0)" ::: "memory"); __syncthreads();
#pragma unroll 1
    for (int k = 0; k < 3; ++k) { const unsigned id = tid + 512u * k, co = id % 192u, tg = id / 192u, g = co / 48u; const int W = 2 << g;
        const LAS unsigned char* base = S + co * 16u + (PSTATE + 4 * tg) * (DPOOL * 2);
        float s[8], x[8];
#pragma unroll
        for (int e = 0; e < 8; ++e) s[e] = 0.f;
        for (int i = 0; i < W; ++i) { lds_row8(base - i * (DPOOL * 2), x);
#pragma unroll
            for (int e = 0; e < 8; ++e) s[e] += x[e]; }
#pragma unroll
        for (int tk = 0; tk < 4; ++tk) {
            if (tk > 0) { float a[8], b[8]; lds_row8(base + tk * (DPOOL * 2), a); lds_row8(base + (tk - W) * (DPOOL * 2), b);
#pragma unroll
                for (int e = 0; e < 8; ++e) s[e] += a[e] - b[e]; }
            lds_row8(base + tk * (DPOOL * 2), x);
            const int pos = pos_u + 4 * (int)tg + tk; const float inv = 1.0f / (float)((pos + 1 < W) ? pos + 1 : W);
            u32x4 o; o.x = cvt_pk_bf16(s[0] * inv - x[0], s[1] * inv - x[1]); o.y = cvt_pk_bf16(s[2] * inv - x[2], s[3] * inv - x[3]);
            o.z = cvt_pk_bf16(s[4] * inv - x[4], s[5] * inv - x[5]); o.w = cvt_pk_bf16(s[6] * inv - x[6], s[7] * inv - x[7]);
            *(GAS u32x4*)((char*)(P + (size_t)(R0 + 4 * tg + tk) * DPOOL) + co * 16u) = o; }
    }
    LDS_WAIT(); __syncthreads();
}
constexpr int PMS_ROWS = 128 + PSTATE, PMS_PITCH = 1024;
__device__ __forceinline__ void poolmix_stage(Frame& F, int unit) {
    LAS unsigned char* S = F.lds; const bf16_t* U = WSP(bf16_t, WS_U);
    const int g = unit & 3, rb = unit >> 2, R0 = rb * 128, pos_u = (rb & 15) * 128;
    unsigned ln = (unsigned)F.lane; asm volatile("" : "+v"(ln));
#pragma unroll 1
    for (int row = F.wave; row < PMS_ROWS; row += NWAVES) { const int rel = row - PSTATE;
        if (pos_u + rel >= 0) __builtin_amdgcn_global_load_lds((const unsigned*)((const char*)(U + (size_t)(R0 + rel) * DPOOL + g * PGRP) + ln * 16u), (LAS unsigned*)(S + row * PMS_PITCH), 16, 0, 0);
        else { unsigned zz = 0u; asm volatile("" : "+v"(zz)); *(LAS u32x4*)(S + row * PMS_PITCH + ln * 16u) = (u32x4){zz, zz, zz, zz}; } }
}
constexpr int PM_ROWS = 128 + PSTATE, PM_PITCH = 1024, PM_PLP = 784;
__device__ __forceinline__ void p2_poolmix_unit(Frame& F, int unit, bool staged = false) {
    LAS unsigned char* S = F.lds;
    const bf16_t* U = WSP(bf16_t, WS_U); const bf16_t* WF = WSP(bf16_t, WS_WPOOLF); const bf16_t* SGA = WSP(bf16_t, WS_SGA); bf16_t* CAT = WSP(bf16_t, WS_CAT);
    const int g = unit & 3, rb = unit >> 2, R0 = rb * 128, pos_u = (rb & 15) * 128;
    unsigned tid = (unsigned)F.tid; asm volatile("" : "+v"(tid));
    const unsigned ln = tid & 63u, fr = ln & 15u, fq = ln >> 4;
    if (!staged) poolmix_stage(F, unit);
    const int n0 = 48 * F.wave;
    constexpr int NKS = PGRP / 32, DEPTH = 3, PM_PO = PGRP * 4 + 16;
    const bf16_t* wb = WF + (size_t)((g * 24 + 3 * F.wave) * NKS) * 512;
    const unsigned woff = ln * 16u;
    bf16x8 bq[DEPTH][3]; u32x4 gA[6], gB[6]; f32x4 ps[3];
#pragma unroll
    for (int d = 0; d < DEPTH; ++d)
#pragma unroll
        for (int j = 0; j < 3; ++j) bq[d][j] = ldg<bf16x8>(wb + (size_t)(j * NKS + d) * 512, woff);
    asm volatile("s_waitcnt vmcnt(0) lgkmcnt(0)" ::: "memory"); __syncthreads();
    const int W = 2 << g;
    u32x4 pv[3][4];
#pragma unroll
    for (int k = 0; k < 3; ++k) { const unsigned id = tid + 512u * k, co = id % 48u, tg = id / 48u;
        const LAS unsigned char* base = S + co * 16u + (PSTATE + 4 * tg) * PM_PITCH;
        float s[8], x[8];
#pragma unroll
        for (int e = 0; e < 8; ++e) s[e] = 0.f;
        for (int i = 0; i < W; ++i) { lds_row8(base - i * PM_PITCH, x);
#pragma unroll
            for (int e = 0; e < 8; ++e) s[e] += x[e]; }
#pragma unroll
        for (int tk = 0; tk < 4; ++tk) {
            if (tk > 0) { float a[8], b[8]; lds_row8(base + tk * PM_PITCH, a); lds_row8(base + (tk - W) * PM_PITCH, b);
#pragma unroll
                for (int e = 0; e < 8; ++e) s[e] += a[e] - b[e]; }
            lds_row8(base + tk * PM_PITCH, x);
            const int pos = pos_u + 4 * (int)tg + tk; const float inv = 1.0f / (float)((pos + 1 < W) ? pos + 1 : W);
            u32x4 o; o.x = cvt_pk_bf16(s[0] * inv - x[0], s[1] * inv - x[1]); o.y = cvt_pk_bf16(s[2] * inv - x[2], s[3] * inv - x[3]);
            o.z = cvt_pk_bf16(s[4] * inv - x[4], s[5] * inv - x[5]); o.w = cvt_pk_bf16(s[6] * inv - x[6], s[7] * inv - x[7]);
            pv[k][tk] = o; }
    }
    LDS_WAIT(); __syncthreads();
#pragma unroll
    for (int k = 0; k < 3; ++k) { const unsigned id = tid + 512u * k, co = id % 48u, tg = id / 48u;
#pragma unroll
        for (int tk = 0; tk < 4; ++tk) *(LAS u32x4*)(S + (4 * tg + tk) * PM_PLP + co * 16u) = pv[k][tk]; }
    LDS_WAIT(); __syncthreads();
    f32x4 acc[8][3];
#pragma unroll
    for (int mi = 0; mi < 8; ++mi)
#pragma unroll
        for (int j = 0; j < 3; ++j) acc[mi][j] = (f32x4){0.f, 0.f, 0.f, 0.f};
#pragma unroll
    for (int j = 0; j < 3; ++j) ps[j] = ldg<f32x4>(F.in[13], ((unsigned)(g * PGRP + n0 + 16 * j) + 4u * fq) * 4u);
    const LAS unsigned char* ap = S + fr * PM_PLP + fq * 16u;
    bf16x8 an[4];
#pragma unroll
    for (int m = 0; m < 4; ++m) an[m] = *(const LAS bf16x8*)(ap + (16 * m) * PM_PLP);
#pragma unroll
    for (int ks = 0; ks < NKS; ++ks) {
        bf16x8 bc[3];
#pragma unroll
        for (int j = 0; j < 3; ++j) bc[j] = bq[ks % DEPTH][j];
        if (ks + DEPTH < NKS) {
#pragma unroll
            for (int j = 0; j < 3; ++j) bq[ks % DEPTH][j] = ldg<bf16x8>(wb + (size_t)(j * NKS + ks + DEPTH) * 512, woff); }
#pragma unroll
        for (int h = 0; h < 2; ++h) { bf16x8 a[4];
#pragma unroll
            for (int m = 0; m < 4; ++m) a[m] = an[m];
            const int hn = (h + 1) & 1, kn = ks + (h == 1 ? 1 : 0);
            if (kn < NKS) {
#pragma unroll
                for (int m = 0; m < 4; ++m) an[m] = *(const LAS bf16x8*)(ap + (16 * (4 * hn + m)) * PM_PLP + 64 * kn); }
#pragma unroll
            for (int m = 0; m < 4; ++m)
#pragma unroll
                for (int j = 0; j < 3; ++j) acc[4 * h + m][j] = __builtin_amdgcn_mfma_f32_16x16x32_bf16(bc[j], a[m], acc[4 * h + m][j], 0, 0, 0); }
    }
    unsigned t2 = tid; asm volatile("" : "+v"(t2));
#pragma unroll
    for (int k = 0; k < 6; ++k) { const unsigned id = t2 + 512u * k, row = id / 48u, c8 = id % 48u;
        gA[k] = ldg<u32x4>(SGA + (size_t)R0 * DPOOL + g * PGRP, (row * (unsigned)DPOOL + 8u * c8) * 2u);
        gB[k] = ldg<u32x4>(SGA + (size_t)(R0 + 64) * DPOOL + g * PGRP, (row * (unsigned)DPOOL + 8u * c8) * 2u); }
#pragma unroll
    for (int h = 0; h < 2; ++h) {
        LDS_WAIT(); __syncthreads();
#pragma unroll
        for (int m = 0; m < 4; ++m)
#pragma unroll
            for (int j = 0; j < 3; ++j) *(LAS f32x4*)(S + (16 * m + fr) * PM_PO + (n0 + 16 * j + 4 * fq) * 4) = acc[4 * h + m][j] * ps[j];
        LDS_WAIT(); __syncthreads();
#pragma unroll
        for (int k = 0; k < 6; ++k) { const unsigned id = t2 + 512u * k, row = id / 48u, c8 = id % 48u;
            const f32x4 v0 = *(const LAS f32x4*)(S + row * PM_PO + c8 * 32u), v1 = *(const LAS f32x4*)(S + row * PM_PO + c8 * 32u + 16u); const u32x4 gg = h ? gB[k] : gA[k];
            u32x4 w; w.x = cvt_pk_bf16(v0[0] * bf_lo(gg.x), v0[1] * bf_hi(gg.x)); w.y = cvt_pk_bf16(v0[2] * bf_lo(gg.y), v0[3] * bf_hi(gg.y));
            w.z = cvt_pk_bf16(v1[0] * bf_lo(gg.z), v1[1] * bf_hi(gg.z)); w.w = cvt_pk_bf16(v1[2] * bf_lo(gg.w), v1[3] * bf_hi(gg.w));
            *(GAS u32x4*)((char*)(CAT + (size_t)(R0 + 64 * h + row) * DM + g * PGRP) + c8 * 16u) = w; }
    }
    LDS_WAIT(); __syncthreads();
}
struct ConvW { f32x2 wp[CW]; float wq[CW]; f32x2 bp; float bq; };
template <bool SAMPLE, int NSEGS = 4> __device__ __forceinline__ void conv_block16(Frame& F, int rowA, const f32x2 (&wp)[CW], const float (&wq)[CW], f32x2 bp, float bq, LAS float* Y) {
    const bf16_t* A = WSP(bf16_t, WS_A);
    unsigned ln = (unsigned)F.lane; asm volatile("" : "+v"(ln));
    const unsigned p = 192u * (unsigned)F.wave + 2u * ln, q = 192u * (unsigned)F.wave + 128u + ln;
    constexpr int NT = SAMPLE ? 4 : 16, NSEG = SAMPLE ? NSEGS : 1, NR = NT + CW - 1, GS = 8, NG = (NR + GS - 1) / GS;
#pragma unroll
    for (int seg = 0; seg < NSEG; ++seg) {
        const int r0 = rowA + seg * NT;
        const int pos0 = SAMPLE ? 0 : (r0 & (SEQ - 1));
        const int bs = (r0 - MP) >> 2;
        f32x2 ap[NT]; float aq[NT];
#pragma unroll
        for (int t = 0; t < NT; ++t) { ap[t] = bp; aq[t] = bq; }
        f32x2 vp[3][GS]; float vq[3][GS];
#define CONV_LOAD(gi) do { _Pragma("unroll") for (int i = 0; i < GS; ++i) { const int rr = (gi) * GS + i; const int rel = rr - (CW - 1); \
            if (rr >= NR) { vp[(gi) % 3][i] = (f32x2){0.f, 0.f}; vq[(gi) % 3][i] = 0.f; } \
            else if (SAMPLE && rel < 0) { const float* sp = F.in[6] + ((size_t)bs * CSTATE + (CSTATE + rel)) * DCONV; vp[(gi) % 3][i] = ldg<f32x2>(sp, p * 4u); vq[(gi) % 3][i] = ldg<float>(sp, q * 4u); } \
            else if (SAMPLE || pos0 + rel >= 0) { const bf16_t* ar = A + (size_t)(r0 + rel) * DCONV; const unsigned w2 = ldg<unsigned>(ar, p * 2u); const unsigned w1 = ldg<unsigned short>(ar, q * 2u); \
                vp[(gi) % 3][i] = (f32x2){bf_lo(w2), bf_hi(w2)}; vq[(gi) % 3][i] = bf_lo(w1); } \
            else { vp[(gi) % 3][i] = (f32x2){0.f, 0.f}; vq[(gi) % 3][i] = 0.f; } } } while (0)
        CONV_LOAD(0); if (NG > 1) CONV_LOAD(1);
#pragma unroll
        for (int gi = 0; gi < NG; ++gi) {
            if (gi + 2 < NG) CONV_LOAD(gi + 2);
#pragma unroll
            for (int i = 0; i < GS; ++i) { const int rr = gi * GS + i;
#pragma unroll
                for (int t = 0; t < NT; ++t) { const int j = rr - t; if (rr < NR && j >= 0 && j < CW) { ap[t] += wp[j] * vp[gi % 3][i]; aq[t] += wq[j] * vq[gi % 3][i]; } } }
            __builtin_amdgcn_sched_barrier(0);
        }
#undef CONV_LOAD
#pragma unroll
        for (int t = 0; t < NT; ++t) { *(LAS f32x2*)(Y + (seg * NT + t) * DCONV + p) = ap[t]; Y[(seg * NT + t) * DCONV + q] = aq[t]; }
    }
}
__device__ __forceinline__ void conv_norm16(Frame& F, int rowA, const LAS float* Y, int ntok = 16) {
    bf16_t* CACT = WSP(bf16_t, WS_CACT);
    unsigned ln = (unsigned)F.lane; asm volatile("" : "+v"(ln));
#pragma unroll
    for (int tt = 0; tt < 2; ++tt) { const int t = 2 * F.wave + tt; if (t >= ntok) break;
        f32x4 y[6]; float s = 0.f;
#pragma unroll
        for (int k = 0; k < 6; ++k) { y[k] = *(const LAS f32x4*)(Y + t * DCONV + 256 * k + 4 * ln); s += (y[k][0] + y[k][1]) + (y[k][2] + y[k][3]); }
        const float mean = wave_sum(s) * (1.0f / DCONV); float qq = 0.f;
#pragma unroll
        for (int k = 0; k < 6; ++k) { y[k] = y[k] - mean; qq += (y[k][0] * y[k][0] + y[k][1] * y[k][1]) + (y[k][2] * y[k][2] + y[k][3] * y[k][3]); }
        const float rstd = 1.0f / sqrtf(wave_sum(qq) * (1.0f / DCONV) + EPS);
        f32x4 gk[6], bk[6];
#pragma unroll
        for (int k = 0; k < 6; ++k) { const unsigned c = 256u * k + 4u * ln; gk[k] = ldg<f32x4>(F.in[16], c * 4u); bk[k] = ldg<f32x4>(F.in[17], c * 4u); }
#pragma unroll
        for (int k = 0; k < 6; ++k) { const unsigned c = 256u * k + 4u * ln; const f32x4 g = gk[k], b = bk[k];
            const f32x4 z = y[k] * rstd * g + b;
            u32x2 o; o.x = cvt_pk_bf16(fast_silu(z[0]), fast_silu(z[1])); o.y = cvt_pk_bf16(fast_silu(z[2]), fast_silu(z[3]));
            *(GAS u32x2*)((char*)(CACT + (size_t)(rowA + t) * DCONV) + c * 2u) = o; }
    }
}
constexpr int CV_ROWS = 16 + CW - 1, CV_STAGE = CV_ROWS * DCONV * 2;
__device__ __forceinline__ void conv_stage(Frame& F, LAS unsigned char* S, int rowA, int pos0, size_t src_off = WS_A) {
    const bf16_t* A = WSP(bf16_t, src_off);
    unsigned ln = (unsigned)F.lane; asm volatile("" : "+v"(ln));
#pragma unroll 1
    for (int i = F.wave; i < CV_ROWS * 3; i += NWAVES) { const int row = i / 3, th = i - 3 * row, rel = row - (CW - 1);
        if (pos0 + rel >= 0) __builtin_amdgcn_global_load_lds((const unsigned*)((const char*)(A + (size_t)(rowA + rel) * DCONV) + th * 1024 + ln * 16u), (LAS unsigned*)(S + i * 1024), 16, 0, 0);
        else *(LAS u32x4*)(S + i * 1024 + ln * 16u) = (u32x4){0u, 0u, 0u, 0u}; }
}
__device__ __forceinline__ void conv_stage_tail(Frame& F, LAS unsigned char* S, int rowA, size_t src_off = WS_A) {
    const bf16_t* A = WSP(bf16_t, src_off);
    unsigned ln = (unsigned)F.lane; asm volatile("" : "+v"(ln));
#pragma unroll 1
    for (int i = F.wave; i < 16 * 3; i += NWAVES) { const int row = i / 3, th = i - 3 * row;
        __builtin_amdgcn_global_load_lds((const unsigned*)((const char*)(A + (size_t)(rowA + row) * DCONV) + th * 1024 + ln * 16u), (LAS unsigned*)(S + i * 1024), 16, 0, 0); }
}
constexpr int CV_TBL = 147456;
__device__ __forceinline__ void p2_conv_unit_prompt(Frame& F, int unit, int next_pm, const ConvW& cw, size_t src_off = WS_A, size_t dst_off = WS_CACT) {
    LAS unsigned char* S = F.lds;
    LAS float* WPT = (LAS float*)(F.lds + CV_TBL);
    LAS float* MR = WPT + 256;
    bf16_t* CACT = WSP(bf16_t, dst_off);
    unsigned ln = (unsigned)F.lane; asm volatile("" : "+v"(ln));
    const unsigned p = 192u * (unsigned)F.wave + 2u * ln, q = 192u * (unsigned)F.wave + 128u + ln;
    f32x2 wp[CW]; float wq[CW];
#pragma unroll
    for (int j = 0; j < CW; ++j) { wp[j] = cw.wp[j]; wq[j] = cw.wq[j]; }
    const f32x2 bp = cw.bp, gp = ldg<f32x2>(F.in[16], p * 4u), hp = ldg<f32x2>(F.in[17], p * 4u);
    const float bq = cw.bq, gq = ldg<float>(F.in[16], q * 4u), hq = ldg<float>(F.in[17], q * 4u);
    const int pos_u = (unit & 63) * 32;
    conv_stage(F, S, unit * 32, pos_u, src_off);
#pragma unroll 1
    for (int h = 0; h < 2; ++h) { const int rowA = unit * 32 + 16 * h;
        const int ringLo = h * 16 * (DCONV * 2), ringHi = -h * (CW - 1) * (DCONV * 2);
        asm volatile("s_waitcnt vmcnt(0) lgkmcnt(0)" ::: "memory"); __syncthreads();
        f32x2 ap[16]; float aq[16];
#pragma unroll
        for (int t = 0; t < 16; ++t) { ap[t] = bp; aq[t] = bq; }
#pragma unroll
        for (int rg = 0; rg < CV_ROWS; rg += 8) {
            unsigned w2[8], w1[8];
#pragma unroll
            for (int i = 0; i < 8; ++i) if (rg + i < CV_ROWS) { const LAS unsigned char* rp = S + (rg + i) * (DCONV * 2) + ((rg + i) < CW - 1 ? ringLo : ringHi);
                w2[i] = *(const LAS unsigned*)(rp + p * 2u); w1[i] = *(const LAS unsigned short*)(rp + q * 2u); }
#pragma unroll
            for (int i = 0; i < 8; ++i) if (rg + i < CV_ROWS) { const int rr = rg + i; const f32x2 vp = (f32x2){bf_lo(w2[i]), bf_hi(w2[i])}; const float vq = bf_lo(w1[i]);
#pragma unroll
                for (int t = 0; t < 16; ++t) { const int j = rr - t; if (j >= 0 && j < CW) { ap[t] += wp[j] * vp; aq[t] += wq[j] * vq; } } }
            __builtin_amdgcn_sched_barrier(0); }
        LDS_WAIT(); __syncthreads();
        if (h == 0) conv_stage_tail(F, S, rowA + 16, src_off);
        else if (next_pm >= 0) poolmix_stage(F, next_pm);
        float st[32];
#pragma unroll
        for (int t = 0; t < 16; ++t) { st[t] = (ap[t].x + ap[t].y) + aq[t]; st[16 + t] = (ap[t].x * ap[t].x + ap[t].y * ap[t].y) + aq[t] * aq[t]; }
        float tot = 0.f;
#pragma unroll
        for (int i = 0; i < 32; ++i) { const float w = wave_sum(st[i]); asm volatile("v_writelane_b32 %0, %1, %2" : "+v"(tot) : "s"(w), "n"(i)); }
        if (ln < 32u) WPT[F.wave * 32 + (int)ln] = tot;
        LDS_WAIT(); __syncthreads();
        if (F.tid < 16) { float s1 = 0.f, s2 = 0.f;
#pragma unroll
            for (int w = 0; w < 8; ++w) { s1 += WPT[w * 32 + F.tid]; s2 += WPT[w * 32 + 16 + F.tid]; }
            const float mean = s1 * (1.0f / DCONV), var = fmaxf(s2 * (1.0f / DCONV) - mean * mean, 0.f);
            MR[2 * F.tid] = mean; MR[2 * F.tid + 1] = 1.0f / sqrtf(var + EPS); }
        LDS_WAIT(); __syncthreads();
#pragma unroll
        for (int t = 0; t < 16; ++t) { const f32x2 mr = *(const LAS f32x2*)(MR + 2 * t);
            const float z0 = (ap[t].x - mr.x) * mr.y * gp.x + hp.x, z1 = (ap[t].y - mr.x) * mr.y * gp.y + hp.y, z2 = (aq[t] - mr.x) * mr.y * gq + hq;
            char* orow = (char*)(CACT + (size_t)(rowA + t) * DCONV);
            *(GAS unsigned*)(orow + p * 2u) = cvt_pk_bf16(fast_silu(z0), fast_silu(z1));
            *(GAS unsigned short*)(orow + q * 2u) = (unsigned short)(cvt_pk_bf16(fast_silu(z2), 0.f) & 0xffffu); }
    }
    LDS_WAIT(); __syncthreads();
}
__device__ __forceinline__ void p2_conv_unit_sample(Frame& F, int bs, const ConvW& cw) {
    LAS float* Y = (LAS float*)F.lds;
    unsigned p = 192u * (unsigned)F.wave + 2u * (unsigned)F.lane, q = 192u * (unsigned)F.wave + 128u + (unsigned)F.lane;
    asm volatile("" : "+v"(p), "+v"(q));
    f32x2 wp[CW]; float wq[CW];
#pragma unroll
    for (int j = 0; j < CW; ++j) { wp[j] = cw.wp[j]; wq[j] = cw.wq[j]; }
    const f32x2 bp = cw.bp; const float bq = cw.bq;
    const int rowA = MP + bs * DS;
    conv_block16<true, 1>(F, rowA, wp, wq, bp, bq, Y);
    LDS_WAIT(); __syncthreads();
    conv_norm16(F, rowA, Y, DS);
    LDS_WAIT(); __syncthreads();
}
__device__ __forceinline__ void stage_tile256(LAS unsigned char* T, const bf16_t* g, int pitch, int tid_) {
    unsigned tid = (unsigned)tid_; asm volatile("" : "+v"(tid));
    const unsigned r5 = tid >> 5, ch = tid & 31u, voff = r5 * (unsigned)pitch * 2u + ch * 16u, loff = r5 * 512u + ((ch ^ (r5 & 15u)) << 4);
    u32x4 v[16];
#pragma unroll
    for (int i = 0; i < 16; ++i) v[i] = ldg<u32x4>(g + (size_t)(16 * i) * pitch, voff);
#pragma unroll
    for (int i = 0; i < 16; ++i) *(LAS u32x4*)(T + loff + i * 8192) = v[i];
}
__device__ __forceinline__ void stage_tile256_load(u32x4 (&v)[16], const bf16_t* g, int pitch, int tid_) {
    unsigned tid = (unsigned)tid_; asm volatile("" : "+v"(tid));
    const unsigned r5 = tid >> 5, ch = tid & 31u, voff = r5 * (unsigned)pitch * 2u + ch * 16u;
#pragma unroll
    for (int i = 0; i < 16; ++i) v[i] = ldg<u32x4>(g + (size_t)(16 * i) * pitch, voff);
}
__device__ __forceinline__ void stage_tile256_store(LAS unsigned char* T, const u32x4 (&v)[16], int tid_) {
    unsigned tid = (unsigned)tid_; asm volatile("" : "+v"(tid));
    const unsigned r5 = tid >> 5, ch = tid & 31u, loff = r5 * 512u + ((ch ^ (r5 & 15u)) << 4);
#pragma unroll
    for (int i = 0; i < 16; ++i) *(LAS u32x4*)(T + loff + i * 8192) = v[i];
}
__device__ __forceinline__ void p2_attn_prompt_unit(Frame& F, int unit) {
    const int qb = unit & 15, h = (unit >> 4) & 3, b = unit >> 6;
    int ln_ = F.lane; asm volatile("" : "+v"(ln_));
    const int fr = ln_ & 15, g = ln_ >> 4;
    const int row = b * SEQ + qb * 128 + F.wave * 16 + fr;
    const bf16_t* Q = WSP(bf16_t, WS_Q); const bf16_t* KP = WSP(bf16_t, WS_KP); const bf16_t* VPT = WSP(bf16_t, WS_VPT); const bf16_t* SGC = WSP(bf16_t, WS_SGC); bf16_t* CAT = WSP(bf16_t, WS_CAT);
    LAS unsigned char* T = F.lds;
    stage_tile256(T, KP + (size_t)(b * NMEM) * DX + h * HD, DX, F.tid);
    bf16x8 qf[8];
#pragma unroll
    for (int ks = 0; ks < 8; ++ks) qf[ks] = *(const GAS bf16x8*)(Q + (size_t)row * DX + h * HD + 32 * ks + 8 * g);
    u32x4 vv[16];
    stage_tile256_load(vv, VPT + (size_t)(h * HD) * DX + b * NMEM, DX, F.tid);
    LDS_WAIT(); __syncthreads();
    f32x4 s[16];
    const int xt = g ^ fr;
#pragma unroll
    for (int nb = 0; nb < 16; ++nb) { s[nb] = (f32x4){0.f, 0.f, 0.f, 0.f}; bf16x8 kf[8];
#pragma unroll
        for (int ks = 0; ks < 8; ++ks) kf[ks] = *(const LAS bf16x8*)(T + (16 * nb + fr) * 512 + (((4 * ks) ^ xt) << 4));
#pragma unroll
        for (int ks = 0; ks < 8; ++ks) s[nb] = __builtin_amdgcn_mfma_f32_16x16x32_bf16(kf[ks], qf[ks], s[nb], 0, 0, 0); }
    float mx = -3.0e38f;
#pragma unroll
    for (int nb = 0; nb < 16; ++nb) mx = fmaxf(fmaxf(fmaxf(s[nb][0], s[nb][1]), fmaxf(s[nb][2], s[nb][3])), mx);
    mx = fmaxf(mx, __shfl_xor(mx, 16)); mx = fmaxf(mx, __shfl_xor(mx, 32));
    const float sc = 0.0625f * 1.44269504089f; float sum = 0.f;
#pragma unroll
    for (int nb = 0; nb < 16; ++nb)
#pragma unroll
        for (int r = 0; r < 4; ++r) { const float p = __builtin_amdgcn_exp2f((s[nb][r] - mx) * sc); s[nb][r] = p; sum += p; }
    sum += __shfl_xor(sum, 16); sum += __shfl_xor(sum, 32);
    const float inv = 1.0f / sum;
    bf16x8 pf[8];
#pragma unroll
    for (int i = 0; i < 8; ++i) { u32x4 w; w.x = cvt_pk_bf16(s[2 * i][0], s[2 * i][1]); w.y = cvt_pk_bf16(s[2 * i][2], s[2 * i][3]); w.z = cvt_pk_bf16(s[2 * i + 1][0], s[2 * i + 1][1]); w.w = cvt_pk_bf16(s[2 * i + 1][2], s[2 * i + 1][3]);
        pf[i] = __builtin_bit_cast(bf16x8, w); }
    const int gcol = (g & 1) ? 16 + 4 * (g - 1) : 4 * g;
    u32x4 gq[8];
#pragma unroll
    for (int k = 0; k < 8; ++k) gq[k] = *(const GAS u32x4*)(SGC + (size_t)row * DX + h * HD + 32 * k + gcol);
    __syncthreads();
    stage_tile256_store(T, vv, F.tid);
    LDS_WAIT(); __syncthreads();
#pragma unroll
    for (int k = 0; k < 8; ++k) {
        u32x2 wab[2];
        unsigned ga0, ga1, gb0, gb1;
        { auto r0 = __builtin_amdgcn_permlane16_swap(gq[k].x, gq[k].z, false, false); auto r1 = __builtin_amdgcn_permlane16_swap(gq[k].y, gq[k].w, false, false);
          ga0 = r0[0]; gb0 = r0[1]; ga1 = r1[0]; gb1 = r1[1]; }
#pragma unroll
        for (int half = 0; half < 2; ++half) { const int eb = 2 * k + half; f32x4 o = (f32x4){0.f, 0.f, 0.f, 0.f};
            u32x2 lo[8], hi[8];
#pragma unroll
            for (int i = 0; i < 8; ++i) { const int e = 16 * eb + fr;
                const LAS unsigned char* rp = T + e * 512 + 8 * (g & 1);
                lo[i] = *(const LAS u32x2*)(rp + (((4 * i + (g >> 1)) ^ fr) << 4)); hi[i] = *(const LAS u32x2*)(rp + (((4 * i + 2 + (g >> 1)) ^ fr) << 4)); }
#pragma unroll
            for (int i = 0; i < 8; ++i) { const u32x4 w = (u32x4){lo[i].x, lo[i].y, hi[i].x, hi[i].y};
                o = __builtin_amdgcn_mfma_f32_16x16x32_bf16(__builtin_bit_cast(bf16x8, w), pf[i], o, 0, 0, 0); }
            const unsigned g0 = half ? gb0 : ga0, g1 = half ? gb1 : ga1;
            wab[half].x = cvt_pk_bf16(o[0] * inv * bf_lo(g0), o[1] * inv * bf_hi(g0)); wab[half].y = cvt_pk_bf16(o[2] * inv * bf_lo(g1), o[3] * inv * bf_hi(g1)); }
        auto s0 = __builtin_amdgcn_permlane16_swap(wab[0].x, wab[1].x, false, false); auto s1 = __builtin_amdgcn_permlane16_swap(wab[0].y, wab[1].y, false, false);
        *(GAS u32x4*)(CAT + (size_t)row * DM + 3072 + h * HD + 32 * k + gcol) = (u32x4){(unsigned)s0[0], (unsigned)s1[0], (unsigned)s0[1], (unsigned)s1[1]}; }
    LDS_WAIT(); __syncthreads();
}
__device__ __forceinline__ void attn_sample_head_unit(Frame& F, int unit) {
    const int b = unit >> 2, head = unit & 3;
    unsigned ln = (unsigned)F.lane; asm volatile("" : "+v"(ln));
    const unsigned hk = ln >> 5, e0 = (ln & 31u) * 4u;
    const bf16_t* Q = WSP(bf16_t, WS_Q); const bf16_t* SGC = WSP(bf16_t, WS_SGC); bf16_t* CAT = WSP(bf16_t, WS_CAT);
    LAS float* SL = (LAS float*)F.lds;
    LAS float* OL = (LAS float*)(F.lds + 4096);
    float q[4][8];
#pragma unroll
    for (int t = 0; t < 4; ++t) { const u32x2 w0 = ldg<u32x2>(Q + (size_t)(MP + b * DS + t) * DX + head * HD, e0 * 2u), w1 = ldg<u32x2>(Q + (size_t)(MP + b * DS + t) * DX + head * HD, (128u + e0) * 2u);
        q[t][0] = bf_lo(w0.x); q[t][1] = bf_hi(w0.x); q[t][2] = bf_lo(w0.y); q[t][3] = bf_hi(w0.y); q[t][4] = bf_lo(w1.x); q[t][5] = bf_hi(w1.x); q[t][6] = bf_lo(w1.y); q[t][7] = bf_hi(w1.y); }
    const float* Kc = F.in[3] + (size_t)b * NMEM * DX + head * HD + (size_t)(32 * F.wave) * DX;
    const float* Vc = F.in[4] + (size_t)b * NMEM * DX + head * HD + (size_t)(32 * F.wave) * DX;
    const unsigned koff = hk * (DX * 4u) + e0 * 4u;
#pragma unroll 1
    for (int kb = 0; kb < 2; ++kb) {
        f32x4 ka[8], kc[8];
#pragma unroll
        for (int j = 0; j < 8; ++j) { const float* pp = Kc + (size_t)(16 * kb + 2 * j) * DX; ka[j] = ldg_nt<f32x4>(pp, koff); kc[j] = ldg_nt<f32x4>(pp, koff + 512u); }
#pragma unroll
        for (int j = 0; j < 8; ++j) { float d[4];
#pragma unroll
            for (int t = 0; t < 4; ++t) d[t] = (ka[j].x * q[t][0] + ka[j].y * q[t][1]) + (ka[j].z * q[t][2] + ka[j].w * q[t][3]) + (kc[j].x * q[t][4] + kc[j].y * q[t][5]) + (kc[j].z * q[t][6] + kc[j].w * q[t][7]);
#pragma unroll
            for (int t = 0; t < 4; ++t) d[t] = half_sum_dpp(d[t]);
            if ((ln & 31u) == 31u) *(LAS f32x4*)(SL + (32 * F.wave + 16 * kb + 2 * j + (int)hk) * 4) = (f32x4){d[0], d[1], d[2], d[3]}; } }
    LDS_WAIT(); __syncthreads();
    if (F.wave < 4) { const int st = F.wave; float v[4]; float mx = -3.0e38f;
#pragma unroll
        for (int i = 0; i < 4; ++i) { v[i] = SL[(ln + 64u * i) * 4 + st]; mx = fmaxf(mx, v[i]); }
#pragma unroll
        for (int o = 1; o < 64; o <<= 1) mx = fmaxf(mx, __shfl_xor(mx, o));
        float sum = 0.f;
#pragma unroll
        for (int i = 0; i < 4; ++i) { v[i] = __builtin_amdgcn_exp2f((v[i] - mx) * (0.0625f * 1.44269504089f)); sum += v[i]; }
        sum = wave_sum(sum); const float inv = 1.0f / sum;
#pragma unroll
        for (int i = 0; i < 4; ++i) SL[(ln + 64u * i) * 4 + st] = v[i] * inv; }
    LDS_WAIT(); __syncthreads();
    float o[4][8];
#pragma unroll
    for (int t = 0; t < 4; ++t)
#pragma unroll
        for (int e = 0; e < 8; ++e) o[t][e] = 0.f;
#pragma unroll 1
    for (int kb = 0; kb < 2; ++kb) {
        f32x4 va[8], vc[8];
#pragma unroll
        for (int j = 0; j < 8; ++j) { const float* pp = Vc + (size_t)(16 * kb + 2 * j) * DX; va[j] = ldg_nt<f32x4>(pp, koff); vc[j] = ldg_nt<f32x4>(pp, koff + 512u); }
#pragma unroll
        for (int j = 0; j < 8; ++j) { const f32x4 pr = *(const LAS f32x4*)(SL + (32 * F.wave + 16 * kb + 2 * j + (int)hk) * 4);
#pragma unroll
            for (int t = 0; t < 4; ++t) { o[t][0] += pr[t] * va[j].x; o[t][1] += pr[t] * va[j].y; o[t][2] += pr[t] * va[j].z; o[t][3] += pr[t] * va[j].w; o[t][4] += pr[t] * vc[j].x; o[t][5] += pr[t] * vc[j].y; o[t][6] += pr[t] * vc[j].z; o[t][7] += pr[t] * vc[j].w; } } }
#pragma unroll
    for (int t = 0; t < 4; ++t)
#pragma unroll
        for (int e = 0; e < 8; ++e) o[t][e] += __shfl_xor(o[t][e], 32);
    if (hk == 0u) {
#pragma unroll
        for (int t = 0; t < 4; ++t) { LAS float* pp = OL + (F.wave * 4 + t) * 256 + e0; *(LAS f32x4*)pp = (f32x4){o[t][0], o[t][1], o[t][2], o[t][3]}; *(LAS f32x4*)(pp + 128) = (f32x4){o[t][4], o[t][5], o[t][6], o[t][7]}; } }
    LDS_WAIT(); __syncthreads();
    if (F.tid < 256) { const int t = F.tid >> 6, e = (F.tid & 63) * 4;
        f32x4 a = (f32x4){0.f, 0.f, 0.f, 0.f};
#pragma unroll
        for (int w = 0; w < 8; ++w) a += *(const LAS f32x4*)(OL + (w * 4 + t) * 256 + e);
        const size_t row = (size_t)(MP + b * DS + t); const int col = head * HD + e;
        const u32x2 gt = *(const GAS u32x2*)(SGC + row * DX + col);
        u32x2 w; w.x = cvt_pk_bf16(a[0] * bf_lo(gt.x), a[1] * bf_hi(gt.x)); w.y = cvt_pk_bf16(a[2] * bf_lo(gt.y), a[3] * bf_hi(gt.y));
        *(GAS u32x2*)(CAT + row * DM + 3072 + col) = w; }
    LDS_WAIT(); __syncthreads();
}

constexpr int NAS_UNITS = DB * NH, NAS_FREE_FROM = G1_ALL - 5 * 256;
constexpr int P2_NAS = 256, P2_NAP = 256, P2_NCV = 256 + MS / 16, P2_NPL = MT / 32;
__device__ __forceinline__ void p2_mixers(LAS unsigned char* lds, const ConvW& cw) {
    if ((int)gridDim.x != 256) { Frame F = make_frame(lds); for (int u = F.vcu; u < NAS_UNITS; u += F.G) attn_sample_head_unit(F, u); }
    { Frame F = make_frame(lds); for (int bs = (F.vcu + F.G - 64) % F.G; bs < DB; bs += F.G) p2_conv_unit_sample(F, bs, cw); }
    { Frame F = make_frame(lds); const bool one = (int)gridDim.x == 256;
      for (int u = F.vcu; u < 256; u += F.G) p2_conv_unit_prompt(F, u, one ? u : -1, cw); }
    { Frame F = make_frame(lds); const bool fused = (int)gridDim.x == 256;
      for (int u = F.vcu; u < 256; u += F.G) p2_poolmix_unit(F, u, fused); }
    { Frame F = make_frame(lds); for (int u = F.vcu; u < P2_NAP; u += F.G) p2_attn_prompt_unit(F, u); }
    { Frame F = make_frame(lds);
      for (int sidx = ((F.vcu + F.G - 192) % F.G) * NWAVES + F.wave; sidx < 16 * 24; sidx += F.G * NWAVES) p2_pool_sample_task(F, sidx); }
    { Frame F = make_frame(lds); p2_states(F); if ((int)gridDim.x != 256) states_copy_rows(F, F.vcu * NWAVES + F.wave, F.G * NWAVES); }
}

struct Sched3pw { int G, c; const char *CACT, *WPW;
    __device__ __forceinline__ bool next(int i, Unit& u) const { const int L = i * G + c; if (L >= G1_NM * 6) return false;
        int pm, pn; pg8::tile_order(L, G1_NM, 6, pm, pn); u.pm = pm; u.pn = pn; u.kind = 0; u.nt = DCONV / 64; u.A = CACT + (size_t)pm * 256 * DCONV * 2; u.B = WPW + (size_t)pn * 256 * DCONV * 2; return true; } };
struct Sched3pl { int G, c; const char *POOLED, *WPOOL;
    __device__ __forceinline__ bool next(int i, Unit& u) const { const int L = i * G + c; if (L >= 2 * 8) return false;
        const int pm = MP / 256 + (L >> 3), pn = L & 7; u.pm = pm; u.pn = pn; u.kind = 1; u.nt = PGRP / 64; const int g = pn >> 1;
        u.A = POOLED + (size_t)pm * 256 * DPOOL * 2 + (size_t)g * PGRP * 2; u.B = WPOOL + (size_t)pn * 256 * PGRP * 2; return true; } };
template <int KIND> struct Epi3 {
    const bf16_t *SGA, *SGB; const float* pscale; bf16_t* CAT;
    __device__ __forceinline__ void operator()(const f32x4 (&acc)[2][2][4][2], const Unit& u, int wr, int wc, int fr, int fq) const {
        const int row0 = u.pm * 256 + wr * 64 + fr, cl = wc * 32 + 8 * fq;
        if constexpr (KIND == 0) {
            const int col0 = u.pn * 256 + cl;
            u32x4 gts[2][4][2];
#pragma unroll
            for (int ai = 0; ai < 2; ++ai)
#pragma unroll
                for (int m = 0; m < 4; ++m)
#pragma unroll
                    for (int bj = 0; bj < 2; ++bj) gts[ai][m][bj] = *(const u32x4*)(SGB + (size_t)(row0 + ai * 128 + m * 16) * DCONV + col0 + bj * 128);
#pragma unroll
            for (int ai = 0; ai < 2; ++ai)
#pragma unroll
                for (int m = 0; m < 4; ++m)
#pragma unroll
                    for (int bj = 0; bj < 2; ++bj) { const size_t r = (size_t)(row0 + ai * 128 + m * 16); const int c = col0 + bj * 128;
                        const u32x4 gt = gts[ai][m][bj]; const f32x4 v0 = acc[ai][bj][m][0], v1 = acc[ai][bj][m][1];
                        u32x4 w; w.x = cvt_pk_bf16(v0[0] * bf_lo(gt.x), v0[1] * bf_hi(gt.x)); w.y = cvt_pk_bf16(v0[2] * bf_lo(gt.y), v0[3] * bf_hi(gt.y));
                        w.z = cvt_pk_bf16(v1[0] * bf_lo(gt.z), v1[1] * bf_hi(gt.z)); w.w = cvt_pk_bf16(v1[2] * bf_lo(gt.w), v1[3] * bf_hi(gt.w));
                        *(u32x4*)(CAT + r * DM + DPOOL + c) = w; }
        } else {
            const int g = u.pn >> 1, half = u.pn & 1;
#pragma unroll
            for (int bj = 0; bj < 2; ++bj) { const int cg = half * 256 + bj * 128 + cl;
                if (!(half == 1 && bj == 1)) { const int c = g * PGRP + cg;
                    const f32x4 s0 = *(const f32x4*)(pscale + c), s1 = *(const f32x4*)(pscale + c + 4);
                    u32x4 gts[2][4];
#pragma unroll
                    for (int ai = 0; ai < 2; ++ai)
#pragma unroll
                        for (int m = 0; m < 4; ++m) gts[ai][m] = *(const u32x4*)(SGA + (size_t)(row0 + ai * 128 + m * 16) * DPOOL + c);
#pragma unroll
                    for (int ai = 0; ai < 2; ++ai)
#pragma unroll
                        for (int m = 0; m < 4; ++m) { const size_t r = (size_t)(row0 + ai * 128 + m * 16);
                            const u32x4 gt = gts[ai][m]; const f32x4 v0 = acc[ai][bj][m][0] * s0, v1 = acc[ai][bj][m][1] * s1;
                            u32x4 w; w.x = cvt_pk_bf16(v0[0] * bf_lo(gt.x), v0[1] * bf_hi(gt.x)); w.y = cvt_pk_bf16(v0[2] * bf_lo(gt.y), v0[3] * bf_hi(gt.y));
                            w.z = cvt_pk_bf16(v1[0] * bf_lo(gt.z), v1[1] * bf_hi(gt.z)); w.w = cvt_pk_bf16(v1[2] * bf_lo(gt.w), v1[3] * bf_hi(gt.w));
                            *(u32x4*)(CAT + r * DM + c) = w; } } }
        }
    }
};

struct Sched4 { int G, c; const char *CAT, *WOUT;
    __device__ __forceinline__ bool next(int i, Unit& u) const {
        constexpr int NPT = (MP / 256) * 16;
        const int L = i * G + c;
        if (L < NPT) { int pm, pn; pg8::tile_order(L, MP / 256, 16, pm, pn); u.pm = pm; u.pn = pn; u.kind = 0; u.nt = DM / 64; u.A = CAT + (size_t)pm * TSTEP4K; u.B = WOUT + (size_t)pn * TSTEP4K; return true; }
        const int q = L - NPT; if (q >= 256) return false;
        const int r = q >> 3, p = q & 7, pm = MP / 256 + (r >> 4), pn = r & 15;
        u.pm = pm; u.pn = pn; u.kind = 1 + p; u.nt = 8; u.A = CAT + (size_t)pm * TSTEP4K + (size_t)p * 1024; u.B = WOUT + (size_t)pn * TSTEP4K + (size_t)p * 1024; return true;
    }
};
__device__ __forceinline__ unsigned pk_f16(float a, float b) { return (unsigned)__builtin_bit_cast(unsigned short, (_Float16)a) | ((unsigned)__builtin_bit_cast(unsigned short, (_Float16)b) << 16); }
__device__ __forceinline__ float h_lo(unsigned w) { return (float)__builtin_bit_cast(_Float16, (unsigned short)(w & 0xffffu)); }
__device__ __forceinline__ float h_hi(unsigned w) { return (float)__builtin_bit_cast(_Float16, (unsigned short)(w >> 16)); }
struct Epi4 {
    unsigned short* y; unsigned short* part;
    __device__ __forceinline__ void operator()(const f32x4 (&acc)[2][2][4][2], const Unit& u, int wr, int wc, int fr, int fq) const {
        const int row0 = u.pm * 256 + wr * 64 + fr, col0 = u.pn * 256 + wc * 32 + 8 * fq;
        if (u.kind == 0) {
            unsigned short* yb = y + (size_t)row0 * DM + col0;
#pragma unroll
            for (int ai = 0; ai < 2; ++ai)
#pragma unroll
                for (int m = 0; m < 4; ++m) { unsigned short* yp = yb + (size_t)(ai * 128 + m * 16) * DM;
                    const f32x4 y0 = acc[ai][0][m][0], y1 = acc[ai][0][m][1], y2 = acc[ai][1][m][0], y3 = acc[ai][1][m][1];
                    *(u32x4*)yp = (u32x4){pk_f16(y0[0], y0[1]), pk_f16(y0[2], y0[3]), pk_f16(y1[0], y1[1]), pk_f16(y1[2], y1[3])}; *(u32x4*)(yp + 128) = (u32x4){pk_f16(y2[0], y2[1]), pk_f16(y2[2], y2[3]), pk_f16(y3[0], y3[1]), pk_f16(y3[2], y3[3])}; }
        } else {
            unsigned short* pb = part + ((size_t)(u.kind - 1) * MS + (size_t)(row0 - MP)) * DM + col0;
#pragma unroll
            for (int ai = 0; ai < 2; ++ai)
#pragma unroll
                for (int m = 0; m < 4; ++m) { unsigned short* pp = pb + (size_t)(ai * 128 + m * 16) * DM;
                    const f32x4 y0 = acc[ai][0][m][0], y1 = acc[ai][0][m][1], y2 = acc[ai][1][m][0], y3 = acc[ai][1][m][1];
                    *(u32x4*)pp = (u32x4){pk_f16(y0[0], y0[1]), pk_f16(y0[2], y0[3]), pk_f16(y1[0], y1[1]), pk_f16(y1[2], y1[3])}; *(u32x4*)(pp + 128) = (u32x4){pk_f16(y2[0], y2[1]), pk_f16(y2[2], y2[3]), pk_f16(y3[0], y3[1]), pk_f16(y3[2], y3[3])}; }
        }
    }
};

template <bool SAMPLE, bool PRE = false> __device__ __forceinline__ void p5_row(Frame& F, int m, float* dst, const f32x4* xpre = nullptr) {
    f32x4 v[16];
    const GAS f32x4* x8 = (const GAS f32x4*)((SAMPLE ? F.in[2] + (size_t)(m - MP) * DM : F.in[0] + (size_t)m * DM)) + 2 * F.lane;
    if (!SAMPLE) {
        const GAS u32x4* yr = (const GAS u32x4*)(F.ws + WS_YH + (size_t)m * DM * 2) + F.lane;
        u32x4 w[8];
#pragma unroll
        for (int j = 0; j < 8; ++j) { w[j] = yr[64 * j]; if constexpr (PRE) { v[2 * j] = xpre[2 * j]; v[2 * j + 1] = xpre[2 * j + 1]; } else { v[2 * j] = x8[128 * j]; v[2 * j + 1] = x8[128 * j + 1]; } }
#pragma unroll
        for (int j = 0; j < 8; ++j) { v[2 * j] += (f32x4){h_lo(w[j].x), h_hi(w[j].x), h_lo(w[j].y), h_hi(w[j].y)}; v[2 * j + 1] += (f32x4){h_lo(w[j].z), h_hi(w[j].z), h_lo(w[j].w), h_hi(w[j].w)}; }
    } else {
#pragma unroll
        for (int j = 0; j < 8; ++j) { v[2 * j] = x8[128 * j]; v[2 * j + 1] = x8[128 * j + 1]; }
#pragma unroll 2
        for (int p = 0; p < 8; ++p) { const GAS u32x4* pr = (const GAS u32x4*)(F.ws + WS_SLAB + ((size_t)p * MS + (m - MP)) * DM * 2) + F.lane;
            u32x4 w[8];
#pragma unroll
            for (int j = 0; j < 8; ++j) w[j] = pr[64 * j];
#pragma unroll
            for (int j = 0; j < 8; ++j) { v[2 * j] += (f32x4){h_lo(w[j].x), h_hi(w[j].x), h_lo(w[j].y), h_hi(w[j].y)}; v[2 * j + 1] += (f32x4){h_lo(w[j].z), h_hi(w[j].z), h_lo(w[j].w), h_hi(w[j].w)}; } }
    }
    float s = 0.f;
#pragma unroll
    for (int j = 0; j < 16; ++j) s += (v[j].x * v[j].x + v[j].y * v[j].y) + (v[j].z * v[j].z + v[j].w * v[j].w);
    const float rstd = 1.0f / sqrtf(wave_sum(s) * (1.0f / DM) + EPS);
    const GAS f32x4* g8 = (const GAS f32x4*)F.in[20] + 2 * F.lane; GAS f32x4* y8 = (GAS f32x4*)(dst + (size_t)m * DM) + 2 * F.lane;
    f32x4 gv[16];
#pragma unroll
    for (int j = 0; j < 8; ++j) { gv[2 * j] = g8[128 * j]; gv[2 * j + 1] = g8[128 * j + 1]; }
#pragma unroll
    for (int j = 0; j < 8; ++j) { y8[128 * j] = v[2 * j] * rstd * gv[2 * j]; y8[128 * j + 1] = v[2 * j + 1] * rstd * gv[2 * j + 1]; }
}
__device__ __forceinline__ void p5_final_norm(Frame& F, float* dst, const f32x4 (&xpre)[16]) {
    const int gw = F.vcu * NWAVES + F.wave, NGW = F.G * NWAVES;
    for (int r = F.wave * F.G + F.vcu; r < MS; r += NGW) p5_row<true>(F, MP + r, dst);
    if (gw < MP) p5_row<false, true>(F, gw, dst, xpre);
    for (int m = gw + NGW; m < MP; m += NGW) p5_row<false>(F, m, dst);
}

__global__ void __launch_bounds__(NTHR, 2) hybrid_fwd(Args args) {
    extern __shared__ __attribute__((aligned(16))) unsigned char lds_raw[];
    LAS unsigned char* lds = (LAS unsigned char*)lds_raw;
    volatile LAS unsigned* MISC = (volatile LAS unsigned*)(lds + LDSCTL_OFF);
    if (threadIdx.x < 64) MISC[threadIdx.x] = 0u;
    __syncthreads();
    XcdBarrier bar = xcd_barrier_post((unsigned*)(args.ws + WS_CTL) + CW_BAR, MISC + 8);

    { Frame F = make_frame(lds); p0_prologue(F, (int)gridDim.x != 256); }
    xcd_barrier(bar);
    { Frame F = make_frame(lds);
      Sched1 S{F.G, (int)blockIdx.x, (const char*)(F.ws + WS_H), (const char*)(F.ws + WS_HM), (const char*)(F.ws + WS_WIN), (const char*)(F.ws + WS_WKV)};
      Epi1 E{WSP(bf16_t, WS_U), WSP(bf16_t, WS_SGA), WSP(bf16_t, WS_A), WSP(bf16_t, WS_SGB), WSP(bf16_t, WS_Q), WSP(bf16_t, WS_SGC), WSP(bf16_t, WS_KP), WSP(bf16_t, WS_VPT), F.out + O_MK, F.out + O_MV, (unsigned*)(F.ws + WS_CTL) + CW_QREADY};
      pg8::gemm_phase<Epi1, Sched1, true, true>(F.lds, DM, DM, S, E); }
    if ((int)blockIdx.x >= NAS_FREE_FROM && (int)gridDim.x == 256) {
        Frame F = make_frame(lds);
        if (F.tid < 64) { unsigned* fl = (unsigned*)(F.ws + WS_CTL) + CW_QREADY; unsigned sp = 0;
            while (__hip_atomic_load(fl, __ATOMIC_RELAXED, __HIP_MEMORY_SCOPE_AGENT) < (unsigned)G1_SPECIAL) { __builtin_amdgcn_s_sleep(4); if (++sp > (1u << 22)) break; }
            __builtin_amdgcn_fence(__ATOMIC_ACQUIRE, "agent"); }
        asm volatile("s_waitcnt vmcnt(0)" ::: "memory"); __syncthreads();
        for (int u = (int)blockIdx.x - NAS_FREE_FROM; u < NAS_UNITS; u += 256 - NAS_FREE_FROM) attn_sample_head_unit(F, u);
    }
    {
        constexpr int NFREE = 256 - NAS_FREE_FROM, N3 = NAS_UNITS - 2 * NFREE, NLATE = NFREE - N3;
        const int idx = (int)blockIdx.x - NAS_FREE_FROM - N3;
        if (idx >= 0 && (int)gridDim.x == 256) { Frame F = make_frame(lds);
            p0_items(F, NITEMS_EARLY, NITEMS, idx * NWAVES + F.wave, NLATE * NWAVES);
            p0_pool_pad(F, idx * NTHR + F.tid, NLATE * NTHR); p0_pool_frag(F, idx * NTHR + F.tid, NLATE * NTHR); }
    }
    if ((int)blockIdx.x >= NAS_FREE_FROM && (int)gridDim.x == 256) {
        Frame F = make_frame(lds); states_copy_rows(F, ((int)blockIdx.x - NAS_FREE_FROM) * NWAVES + F.wave, (256 - NAS_FREE_FROM) * NWAVES); }
    ConvW cw;
    { const XbState xs = xcd_barrier_arrive(bar);
      unsigned ln = threadIdx.x & 63u; asm volatile("" : "+v"(ln)); const unsigned wv = threadIdx.x >> 6;
      const unsigned p = 192u * wv + 2u * ln, q = 192u * wv + 128u + ln; const float* w = args.in[14]; const float* bb = args.in[15];
#pragma unroll
      for (int j = 0; j < CW; ++j) { cw.wp[j] = ldg<f32x2>(w + (size_t)j * DCONV, p * 4u); cw.wq[j] = ldg<float>(w + (size_t)j * DCONV, q * 4u); }
      cw.bp = ldg<f32x2>(bb, p * 4u); cw.bq = ldg<float>(bb, q * 4u);
      xcd_barrier_wait(bar, xs); }
    p2_mixers(lds, cw);
    { const XbState xs = xcd_barrier_arrive(bar);
      Frame F = make_frame(lds);
      Epi3<0> E{WSP(bf16_t, WS_SGA), WSP(bf16_t, WS_SGB), F.in[13], WSP(bf16_t, WS_CAT)};
      Sched3pw Sw{F.G, (int)blockIdx.x, (const char*)(F.ws + WS_CACT), (const char*)(F.ws + WS_WPW)};
      pg8::prestage_B(F.lds, DCONV, Sw);
      xcd_barrier_wait(bar, xs);
      pg8::gemm_phase<Epi3<0>, Sched3pw, true, true, true>(F.lds, DCONV, DCONV, Sw, E); }
    { Frame F = make_frame(lds);
      Epi3<1> E{WSP(bf16_t, WS_SGA), WSP(bf16_t, WS_SGB), F.in[13], WSP(bf16_t, WS_CAT)};
      Sched3pl Sp{F.G, (int)((blockIdx.x + 52) % F.G), (const char*)(F.ws + WS_POOLED), (const char*)(F.ws + WS_WPOOL)};
      pg8::gemm_phase<Epi3<1>, Sched3pl, true, true>(F.lds, DPOOL, PGRP, Sp, E); }
    { const XbState xs = xcd_barrier_arrive(bar);
      Frame F = make_frame(lds);
      Sched4 S{F.G, (int)blockIdx.x, (const char*)(F.ws + WS_CAT), (const char*)(F.ws + WS_WOUT)};
      Epi4 E{(unsigned short*)(F.ws + WS_YH), (unsigned short*)(F.ws + WS_SLAB)};
      pg8::prestage_B(F.lds, DM, S);
      xcd_barrier_wait(bar, xs);
      pg8::gemm_phase<Epi4, Sched4, true, true, true>(F.lds, DM, DM, S, E); }
    f32x4 xpre[16];
    { const XbState xs = xcd_barrier_arrive(bar);
      const int bx0 = (int)blockIdx.x, G0 = (int)gridDim.x, vcu0 = (G0 % 8 == 0) ? (bx0 % 8) * (G0 / 8) + bx0 / 8 : bx0;
      const int gw0 = vcu0 * NWAVES + (int)(threadIdx.x >> 6); unsigned ln = threadIdx.x & 63u; asm volatile("" : "+v"(ln));
      const float* xr = args.in[0] + (size_t)(gw0 < MP ? gw0 : 0) * DM;
#pragma unroll
      for (int j = 0; j < 8; ++j) { xpre[2 * j] = ldg<f32x4>(xr, (128u * j + 2u * ln) * 16u); xpre[2 * j + 1] = ldg<f32x4>(xr, (128u * j + 2u * ln + 1u) * 16u); }
      xcd_barrier_wait(bar, xs); }
    { Frame F = make_frame(lds); p5_final_norm(F, F.out + O_Y, xpre); }
}

extern "C" void kernel_launch(void* const* d_in, const int* in_sizes, int n_in, void* d_out, int out_size, void* d_ws, size_t ws_size, hipStream_t stream) {
    static int grid = 0;
    if (grid == 0) {
        if (n_in != 21 || (size_t)out_size != O_END || ws_size < WS_END) { fprintf(stderr, "kernel_launch: unexpected shapes: n_in %d out %d ws %zu (need %zu)\n", n_in, out_size, ws_size, (size_t)WS_END); grid = -1; return; }
        int dev = 0, cus = 0, per_cu = 0;
        if (hipGetDevice(&dev) != hipSuccess || hipDeviceGetAttribute(&cus, hipDeviceAttributeMultiprocessorCount, dev) != hipSuccess) { grid = -1; return; }
        if (hipFuncSetAttribute((const void*)hybrid_fwd, hipFuncAttributeMaxDynamicSharedMemorySize, LDS_BYTES) != hipSuccess) { fprintf(stderr, "kernel_launch: hipFuncSetAttribute failed\n"); grid = -1; return; }
        if (hipOccupancyMaxActiveBlocksPerMultiprocessor(&per_cu, (const void*)hybrid_fwd, NTHR, LDS_BYTES) != hipSuccess || per_cu < 1) { fprintf(stderr, "kernel_launch: occupancy query reports %d blocks per CU\n", per_cu); }
        (void)hipGetLastError();
        grid = cus;
    }
    if (grid < 0) return;
    unsigned char* wsb = (unsigned char*)d_ws + ((ws_size - WS_END) & ~(size_t)(2 * MiB - 1));
    if (hipMemsetAsync((char*)wsb + WS_CTL, 0, CTL_ZERO_BYTES, stream) != hipSuccess) { fprintf(stderr, "kernel_launch: memset failed\n"); return; }
    Args a{};
    for (int i = 0; i < 21; ++i) a.in[i] = (const float*)d_in[i];
    a.out = (float*)d_out; a.ws = wsb;
    hipLaunchKernelGGL(hybrid_fwd, dim3(grid), dim3(NTHR), LDS_BYTES, stream, a);
}
```
